# Optimizing an MI355X kernel written in HIP

```python
import jax, jax.numpy as jnp
from jax import lax
import numpy as np

D_MODEL = 2048
BATCH = 4
SEQ = 8192
DEPTH = 1
DEC_BATCH = 32
DEC_SEQ = 64
PAST_LEN = 1024

CHUNK = 64
D_MIX = D_MODEL
D_A = D_MIX // 2
D_B = D_MIX - D_A
SGU_CHUNK = 128
A_HEADS = 8
A_HEAD_DIM = D_A // A_HEADS
B_HEAD_DIM = 64
B_HEADS = D_B // B_HEAD_DIM
LORA_W = 64
LORA_A = 64
N_SHIFT = 3 * D_B + LORA_W + LORA_A
D_PROJ = 3 * D_A + N_SHIFT + D_B
NORM_EPS = 1e-6
LN_EPS = 1e-5
GN_EPS = 64e-5
W_OFFSET = 0.5

kernel_name = "hybrid_gmlp_rwkv7_stream_step"


def rms_norm(x, g):
    xf = x.astype(jnp.float32)
    y = xf * lax.rsqrt(jnp.mean(xf * xf, axis=-1, keepdims=True) + NORM_EPS)
    return (y * g.astype(jnp.float32)).astype(x.dtype)


def layer_norm(x, g, b):
    xf = x.astype(jnp.float32)
    mu = jnp.mean(xf, axis=-1, keepdims=True)
    var = jnp.mean(jnp.square(xf - mu), axis=-1, keepdims=True)
    y = (xf - mu) * lax.rsqrt(var + LN_EPS)
    return (y * g.astype(jnp.float32) + b.astype(jnp.float32)).astype(x.dtype)


def token_shift(z, prev, mu):
    z_prev = jnp.concatenate([prev.astype(z.dtype), z[:, :-1]], axis=1)
    return z + mu * (z_prev - z)


def sgu_mix(vn, w_s, b_s):
    L = vn.shape[2]
    mask = jnp.tril(jnp.ones((L, L), dtype=bool))
    w = jnp.where(mask[None], w_s[:, :L, :L], jnp.zeros((), w_s.dtype)).astype(vn.dtype)
    f = jnp.einsum('hij,bcjhd->bcihd', w, vn)
    return f + b_s[:, :L].T[None, None, :, :, None].astype(vn.dtype)


def wkv7_scan(S0, r, w, k, v, kk, b):
    def step(S, inp):
        r_t, w_t, k_t, v_t, kk_t, b_t = inp
        sa = -jnp.einsum('bhvk,bhk->bhv', S, kk_t)
        S = (S * w_t[:, :, None, :] + sa[..., None] * b_t[:, :, None, :]
             + v_t[..., None] * k_t[:, :, None, :])
        y = jnp.einsum('bhvk,bhk->bhv', S, r_t)
        return S, y
    xs = tuple(jnp.swapaxes(t, 0, 1) for t in (r, w, k, v, kk, b))
    S, ys = lax.scan(step, S0, xs)
    return jnp.swapaxes(ys, 0, 1), S


def hybrid_layer(x, wkv0, shift0, norm_g, w_in, w_out, sgu_ln_g, sgu_ln_b, sgu_w, sgu_b,
                 shift_mu, w0, w2, a0, a2, k_k, k_a, r_k, gn_g, gn_b):
    bsz, t, _ = x.shape
    f32 = jnp.float32
    h = rms_norm(x, norm_g)
    z = h @ w_in
    za, zs, g_b = jnp.split(z, [3 * D_A, 3 * D_A + N_SHIFT], axis=-1)

    u, v, g_a = jnp.split(za, 3, axis=-1)
    vn = layer_norm(jax.nn.gelu(v, approximate=False), sgu_ln_g, sgu_ln_b)
    L = min(t, SGU_CHUNK)
    f = sgu_mix(vn.reshape(bsz, t // L, L, A_HEADS, A_HEAD_DIM), sgu_w, sgu_b).reshape(bsz, t, D_A)
    out_a = jax.nn.gelu(u, approximate=False) * f * jax.nn.silu(g_a)

    new_shift = zs[:, -1:]
    zs_mix = token_shift(zs, shift0, shift_mu).astype(f32)
    r, k, vb, hw, ha = jnp.split(zs_mix, [D_B, 2 * D_B, 3 * D_B, 3 * D_B + LORA_W], axis=-1)
    d = w0.astype(f32) + jnp.tanh(hw) @ w2.astype(f32)
    decay = jnp.exp(-jnp.exp(-jax.nn.softplus(-d) - W_OFFSET))
    a = jax.nn.sigmoid(a0.astype(f32) + ha @ a2.astype(f32))
    hs = (bsz, t, B_HEADS, B_HEAD_DIM)
    kk = (k * k_k.astype(f32)).reshape(hs)
    kk = kk / jnp.maximum(jnp.linalg.norm(kk, axis=-1, keepdims=True), 1e-12)
    k = k * (1.0 + (a - 1.0) * k_a.astype(f32))
    r_h, k_h, v_h, a_h = r.reshape(hs), k.reshape(hs), vb.reshape(hs), a.reshape(hs)
    y, S = wkv7_scan(wkv0.astype(f32), r_h, decay.reshape(hs), k_h, v_h, kk, kk * a_h)
    mu = jnp.mean(y, axis=-1, keepdims=True)
    var = jnp.mean(jnp.square(y - mu), axis=-1, keepdims=True)
    y = ((y - mu) * lax.rsqrt(var + GN_EPS)).reshape(bsz, t, D_B)
    y = y * gn_g.astype(f32) + gn_b.astype(f32)
    bonus = jnp.sum(r_h * k_h * r_k.astype(f32), axis=-1, keepdims=True) * v_h
    y = y + bonus.reshape(bsz, t, D_B)
    out_b = y.astype(x.dtype) * jax.nn.silu(g_b)

    o = jnp.concatenate([out_a, out_b], axis=-1) @ w_out
    return x + o, S, new_shift, vn


def setup_inputs(seed: int = 0) -> dict:
    key = jax.random.key(seed)
    ks = jax.random.split(key, 24)
    nrm = lambda k, s, sc: jax.random.normal(k, s, jnp.float32) * sc
    return {
        "x_prompt": nrm(ks[0], (BATCH, SEQ, D_MODEL), 1.0),
        "x_sample": nrm(ks[1], (DEC_BATCH, DEC_SEQ, D_MODEL), 1.0),
        "state_b_wkv": nrm(ks[2], (DEPTH, DEC_BATCH, B_HEADS, B_HEAD_DIM, B_HEAD_DIM), 0.5),
        "state_b_shift": nrm(ks[3], (DEPTH, DEC_BATCH, 1, N_SHIFT), 1.0),
        "norm_g": 1.0 + nrm(ks[4], (DEPTH, D_MODEL), 0.02),
        "w_in": nrm(ks[5], (DEPTH, D_MODEL, D_PROJ), D_MODEL ** -0.5),
        "w_out": nrm(ks[6], (DEPTH, D_MIX, D_MODEL), 0.5 * D_MIX ** -0.5),
        "sgu_ln_g": 1.0 + nrm(ks[7], (DEPTH, D_A), 0.02),
        "sgu_ln_b": nrm(ks[8], (DEPTH, D_A), 0.02),
        "sgu_w": nrm(ks[9], (DEPTH, A_HEADS, SGU_CHUNK, SGU_CHUNK), SGU_CHUNK ** -0.5),
        "sgu_b": 1.0 + nrm(ks[10], (DEPTH, A_HEADS, SGU_CHUNK), 0.1),
        "shift_mu": jax.random.uniform(ks[11], (DEPTH, N_SHIFT), jnp.float32),
        "w0": -3.0 + nrm(ks[12], (DEPTH, D_B), 1.0),
        "w2": nrm(ks[13], (DEPTH, LORA_W, D_B), 0.5 * LORA_W ** -0.5),
        "a0": nrm(ks[14], (DEPTH, D_B), 0.5),
        "a2": nrm(ks[15], (DEPTH, LORA_A, D_B), 0.5 * LORA_A ** -0.5),
        "k_k": 0.85 + nrm(ks[16], (DEPTH, D_B), 0.05),
        "k_a": 1.0 + nrm(ks[17], (DEPTH, D_B), 0.05),
        "r_k": nrm(ks[18], (DEPTH, B_HEADS, B_HEAD_DIM), 0.1),
        "gn_g": 1.0 + nrm(ks[19], (DEPTH, D_B), 0.02),
        "gn_b": nrm(ks[20], (DEPTH, D_B), 0.02),
        "final_g": 1.0 + nrm(ks[21], (D_MODEL,), 0.02),
    }


def reference(x_prompt, x_sample, state_b_wkv, state_b_shift, norm_g, w_in, w_out, sgu_ln_g, sgu_ln_b,
              sgu_w, sgu_b, shift_mu, w0, w2, a0, a2, k_k, k_a, r_k, gn_g, gn_b, final_g):
    yp, ys = x_prompt, x_sample
    bp = x_prompt.shape[0]
    zero_wkv = jnp.zeros((bp, B_HEADS, B_HEAD_DIM, B_HEAD_DIM), jnp.float32)
    zero_shift = jnp.zeros((bp, 1, N_SHIFT), x_prompt.dtype)
    wkv_p, shift_p, wkv_s, shift_s, sgu_v_s = [], [], [], [], []
    for l in range(DEPTH):
        lw = [p[l] for p in (norm_g, w_in, w_out, sgu_ln_g, sgu_ln_b, sgu_w, sgu_b, shift_mu,
                             w0, w2, a0, a2, k_k, k_a, r_k, gn_g, gn_b)]
        yp, S_p, sh_p, _ = hybrid_layer(yp, zero_wkv, zero_shift, *lw)
        ys, S_s, sh_s, vn_s = hybrid_layer(ys, state_b_wkv[l], state_b_shift[l], *lw)
        wkv_p.append(S_p); shift_p.append(sh_p)
        wkv_s.append(S_s); shift_s.append(sh_s); sgu_v_s.append(vn_s)
    y_prompt = rms_norm(yp, final_g)
    y_sample = rms_norm(ys, final_g)
    new_wkv_prompt = jnp.stack(wkv_p)
    new_shift_prompt = jnp.stack(shift_p)
    new_wkv_sample = jnp.stack(wkv_s)
    new_shift_sample = jnp.stack(shift_s)
    new_sgu_v_sample = jnp.stack(sgu_v_s)
    return (y_prompt, y_sample, new_wkv_prompt, new_shift_prompt, new_wkv_sample, new_shift_sample, new_sgu_v_sample)
```

```cpp
#include <hip/hip_runtime.h>
#include <hip/hip_cooperative_groups.h>
#include <cstdio>
namespace cg = cooperative_groups;

#ifndef MEGA
#define MEGA 1
#endif

#define LAS __attribute__((address_space(3)))
typedef unsigned short bf16_t;
typedef short bf16x8 __attribute__((ext_vector_type(8)));
typedef float f32x4 __attribute__((ext_vector_type(4)));
typedef float f32x2 __attribute__((ext_vector_type(2)));
typedef unsigned u32x4 __attribute__((ext_vector_type(4)));
typedef unsigned u32x2 __attribute__((ext_vector_type(2)));

constexpr int DM = 2048, MP = 32768, MS = 2048, MT = MP + MS;
constexpr int SEQ = 8192, DSEQ = 64, NSHIFT = 3200, DPROJ = 7296, LDZ = 7424;
constexpr int ZC_V = 1024, ZC_GA = 2048, ZC_S = 3072, ZC_GB = 6272;
constexpr size_t O_YP = 0, O_WKVP = 71303168, O_SHP = 71565312, O_WKVS = 71578112, O_SHS = 73675264, O_SGUV = 73777664;
constexpr int LDS_BYTES = 163840;

struct Params {
    const float *x_prompt, *x_sample, *st_wkv, *st_shift, *norm_g, *w_in, *w_out, *ln_g, *ln_b, *sgu_w, *sgu_b, *mu, *w0, *w2, *a0, *a2, *k_k, *k_a, *r_k, *gn_g, *gn_b, *final_g;
    float* out;
    bf16_t *Z, *XB, *ACT, *WTI, *WTO, *PV, *QG, *AQBG, *YVG, *UTG, *W1G, *BPG, *U0G, *VKG;
    float *PRK, *GCG; unsigned* BAR;
};

typedef __bf16 bf16v2 __attribute__((ext_vector_type(2)));
__device__ __forceinline__ unsigned pk_bf16(float lo, float hi) { const f32x2 v = (f32x2){lo, hi}; const bf16v2 b = __builtin_convertvector(v, bf16v2); return __builtin_bit_cast(unsigned, b); }
__device__ __forceinline__ float bf_lo(unsigned u) { return __uint_as_float(u << 16); }
__device__ __forceinline__ float bf_hi(unsigned u) { return __uint_as_float(u & 0xffff0000u); }
__device__ __forceinline__ float bf2f(bf16_t b) { return __uint_as_float(((unsigned)b) << 16); }
__device__ __forceinline__ bf16_t f2bf(float f) { return (bf16_t)(pk_bf16(f, 0.f) & 0xffffu); }
__device__ __forceinline__ float wave_sum(float v) {
#pragma unroll
    for (int o = 32; o > 0; o >>= 1) v += __shfl_xor(v, o);
    return v;
}
__device__ __forceinline__ float sigmoid_f(float x) { return __builtin_amdgcn_rcpf(1.0f + __builtin_amdgcn_exp2f(-1.44269504089f * x)); }
__device__ __forceinline__ float tanh_f(float x) { return 1.0f - 2.0f * __builtin_amdgcn_rcpf(1.0f + __builtin_amdgcn_exp2f(2.88539008178f * x)); }
__device__ __forceinline__ float silu_f(float x) { return x * __builtin_amdgcn_rcpf(1.0f + __builtin_amdgcn_exp2f(-1.44269504089f * x)); }
__device__ __forceinline__ float gelu_f(float v) {
    const float av = fabsf(v), t = __builtin_amdgcn_rcpf(av * 0.2316418882f + 1.0f);
    float q = t * 0.5307027145f + (-0.7265760135f); q = q * t + 0.7107068705f; q = q * t + (-0.142248368f); q = q * t + 0.127414796f; q = q * t;
    const float e = __builtin_amdgcn_exp2f((v * v) * (-0.72134752044f));
    const float m = v * (q * e);
    return v < 0.f ? m : v - m;
}
__device__ __forceinline__ f32x2 gelu2(f32x2 v) {
    const f32x2 av = __builtin_elementwise_abs(v), d = av * 0.2316418882f + 1.0f;
    f32x2 t; t.x = __builtin_amdgcn_rcpf(d.x); t.y = __builtin_amdgcn_rcpf(d.y);
    f32x2 q = t * 0.5307027145f + (-0.7265760135f); q = q * t + 0.7107068705f; q = q * t + (-0.142248368f); q = q * t + 0.127414796f; q = q * t;
    const f32x2 s = (v * v) * (-0.72134752044f);
    f32x2 e; e.x = __builtin_amdgcn_exp2f(s.x); e.y = __builtin_amdgcn_exp2f(s.y);
    const f32x2 m = v * (q * e), r = v - m;
    f32x2 o; o.x = v.x < 0.f ? m.x : r.x; o.y = v.y < 0.f ? m.y : r.y; return o;
}
__device__ __forceinline__ f32x2 silu2(f32x2 v) {
    const f32x2 s = v * (-1.44269504089f);
    f32x2 e; e.x = __builtin_amdgcn_exp2f(s.x); e.y = __builtin_amdgcn_exp2f(s.y);
    const f32x2 d = e + 1.0f;
    f32x2 r; r.x = __builtin_amdgcn_rcpf(d.x); r.y = __builtin_amdgcn_rcpf(d.y);
    return v * r;
}
__device__ __forceinline__ f32x2 bf2(unsigned u) { return (f32x2){bf_lo(u), bf_hi(u)}; }
__device__ __forceinline__ const float* xrow(const Params& p, int row) { return row < MP ? p.x_prompt + (size_t)row * DM : p.x_sample + (size_t)(row - MP) * DM; }
__device__ __forceinline__ bool seq_first(int row) { return row < MP ? (row & (SEQ - 1)) == 0 : ((row - MP) & (DSEQ - 1)) == 0; }

namespace pg8 {
constexpr int BM = 256, BK = 64, HALF = 128, HTB = HALF * BK * 2, STAGE_BYTES = 8 * HTB, NXCD = 8, WGM = 8;
__host__ __device__ __forceinline__ int lds_byte(int r, int c) { const int st = (r >> 4) * 2 + (c >> 5), rr = r & 15, cc = c & 31, ob = rr * 64 + cc * 2; return st * 1024 + (ob ^ (((ob >> 9) & 1) << 5)); }
__host__ __device__ __forceinline__ void stage_rc(int b, int& R, int& C) { const int st = b / 1024, sb = b % 1024, swz = sb ^ (((sb >> 9) & 1) << 5); R = (st >> 1) * 16 + swz / 64; C = (st & 1) * 32 + (swz % 64) / 2; }
__host__ __device__ __forceinline__ int perm32(int rho) { const int n = rho >> 4, i = rho & 15; return 8 * (i >> 2) + 4 * n + (i & 3); }
struct Unit { int pm, pn; };
struct Gemm { const bf16_t* A; const bf16_t* Bt; int M, N, K; };
struct StaticOrder {
    int nM, nN, nwg, G, c;
    __device__ void init(int M, int N, int G_, int c_) { nM = M / BM; nN = N / BM; nwg = nM * nN; G = G_; c = c_; }
    __device__ bool next(int i, Unit& u) const {
        const long L = (long)i * G + c; if (L >= nwg) return false;
        int wgid = (int)L; { const int q = nwg / NXCD, r = nwg % NXCD, xcd = wgid % NXCD, off = wgid / NXCD; wgid = (xcd < r ? xcd * (q + 1) : r * (q + 1) + (xcd - r) * q) + off; }
        const int nig = WGM * nN, gid = wgid / nig, fm = gid * WGM, gsz = (nM - fm) < WGM ? (nM - fm) : WGM;
        u.pm = fm + ((wgid % nig) % gsz); u.pn = (wgid % nig) / gsz; return true;
    }
};

template <class Epi>
__device__ __forceinline__ void gemm_phase(LAS unsigned char* lds, const Gemm g, const StaticOrder& S, const Epi& E) {
    const int tid = threadIdx.x, wid = __builtin_amdgcn_readfirstlane(tid >> 6), lane = tid & 63, wr = wid >> 2, wc = wid & 3, fr = lane & 15, fq = lane >> 4;
    const int K = g.K, nt = K / BK;
    unsigned voffA[2], voffB[2];
#pragma unroll
    for (int i = 0; i < 2; ++i) { int R, C; stage_rc(tid * 16 + i * 8192, R, C); const int Rb = Epi::PERM ? ((R & ~31) + perm32(R & 31)) : R;
        voffA[i] = (unsigned)(R * K + C) * 2u; voffB[i] = (unsigned)(Rb * K + C) * 2u; }
    const size_t kstep = (size_t)(BK * 2);
    const size_t hstep = (size_t)HALF * K * 2;
    const size_t tstep = 2 * hstep;
    const unsigned ldsw = (unsigned)wid * 1024u;
    const int aoff = lds_byte(wr * 64 + fr, fq * 8), boff = lds_byte(wc * 32 + fr, fq * 8);
#define PG8_SA(b, h) (((b) * 2 + (h)) * HTB)
#define PG8_SB(b, h) ((4 + (b) * 2 + (h)) * HTB)
#define PG8_STAGE(bufoff, gbase, voff) do { _Pragma("unroll") for (int _i = 0; _i < 2; ++_i) \
        __builtin_amdgcn_global_load_lds((const unsigned*)((const char*)(gbase) + (voff)[_i]), (LAS unsigned*)(lds + (bufoff) + ldsw + _i * 8192), 16, 0, 0); } while (0)
#define PG8_LDA(dst, b, h) do { _Pragma("unroll") for (int m = 0; m < 4; ++m) _Pragma("unroll") for (int k = 0; k < 2; ++k) dst[m][k] = *(const LAS bf16x8*)(lds + PG8_SA(b, h) + aoff + m * 2048 + k * 1024); } while (0)
#define PG8_LDB(dst, b, h) do { _Pragma("unroll") for (int n = 0; n < 2; ++n) _Pragma("unroll") for (int k = 0; k < 2; ++k) dst[n][k] = *(const LAS bf16x8*)(lds + PG8_SB(b, h) + boff + n * 2048 + k * 1024); } while (0)
#define PG8_MMA(ai, bj, At, Bt) do { __builtin_amdgcn_s_setprio(1); _Pragma("unroll") for (int m = 0; m < 4; ++m) _Pragma("unroll") for (int n = 0; n < 2; ++n) _Pragma("unroll") for (int k = 0; k < 2; ++k) \
        acc[ai][bj][m][n] = __builtin_amdgcn_mfma_f32_16x16x32_bf16(Bt[n][k], At[m][k], acc[ai][bj][m][n], 0, 0, 0); __builtin_amdgcn_s_setprio(0); } while (0)
#define PG8_WAIT_V(n) asm volatile("s_waitcnt vmcnt(" #n ")" ::: "memory")
#define PG8_WAIT_L(n) asm volatile("s_waitcnt lgkmcnt(" #n ")" ::: "memory")
#define PG8_BAR __builtin_amdgcn_s_barrier()
#define PG8_SCHED __builtin_amdgcn_sched_barrier(0)
    Unit cur, nxt; int ui = 0;
    if (!S.next(0, cur)) return;
    f32x4 acc[2][2][4][2];
#pragma unroll
    for (int a = 0; a < 2; ++a)
#pragma unroll
        for (int b = 0; b < 2; ++b)
#pragma unroll
            for (int m = 0; m < 4; ++m)
#pragma unroll
                for (int n = 0; n < 2; ++n) acc[a][b][m][n] = (f32x4){0.f, 0.f, 0.f, 0.f};
    bf16x8 At[4][2], B0[2][2], B1[2][2];
    const char* cA = (const char*)g.A + (size_t)cur.pm * tstep; const char* cB = (const char*)g.Bt + (size_t)cur.pn * tstep;
    PG8_STAGE(PG8_SB(0, 0), cB, voffB); PG8_STAGE(PG8_SA(0, 0), cA, voffA); PG8_STAGE(PG8_SB(0, 1), cB + hstep, voffB); PG8_STAGE(PG8_SA(0, 1), cA + hstep, voffA);
    if (wr == 1) PG8_BAR;
    PG8_WAIT_V(4); PG8_BAR;
    PG8_STAGE(PG8_SB(1, 0), cB + kstep, voffB); PG8_STAGE(PG8_SA(1, 0), cA + kstep, voffA); PG8_STAGE(PG8_SB(1, 1), cB + hstep + kstep, voffB);
    PG8_WAIT_V(6); PG8_BAR;
    for (;;) {
        const bool has_next = S.next(ui + 1, nxt);
        const char* nA = has_next ? (const char*)g.A + (size_t)nxt.pm * tstep : cA; const char* nB = has_next ? (const char*)g.Bt + (size_t)nxt.pn * tstep : cB;
        for (int t = 0; t < nt; t += 2) {
            const bool last = (t == nt - 2);
            const char* a1 = cA + (size_t)(t + 1) * kstep;
            const char* a2 = last ? nA : cA + (size_t)(t + 2) * kstep; const char* b2 = last ? nB : cB + (size_t)(t + 2) * kstep;
            const char* a3 = a2 + kstep; const char* b3 = b2 + kstep;
            PG8_LDB(B0, 0, 0); PG8_SCHED; PG8_LDA(At, 0, 0); PG8_STAGE(PG8_SA(1, 1), a1 + hstep, voffA);
            PG8_WAIT_L(8); PG8_BAR; PG8_WAIT_L(0); PG8_MMA(0, 0, At, B0); PG8_BAR; PG8_SCHED;
            PG8_LDB(B1, 0, 1); PG8_STAGE(PG8_SB(0, 0), b2, voffB);
            PG8_BAR; PG8_WAIT_L(0); PG8_MMA(0, 1, At, B1); PG8_BAR;
            PG8_LDA(At, 0, 1); PG8_STAGE(PG8_SA(0, 0), a2, voffA);
            PG8_BAR; PG8_WAIT_L(0); PG8_MMA(1, 0, At, B0); PG8_BAR; PG8_SCHED;
            PG8_STAGE(PG8_SB(0, 1), b2 + hstep, voffB);
            PG8_WAIT_V(6); PG8_BAR; PG8_MMA(1, 1, At, B1); PG8_BAR;
            PG8_LDB(B0, 1, 0); PG8_SCHED; PG8_LDA(At, 1, 0); PG8_STAGE(PG8_SA(0, 1), a2 + hstep, voffA);
            PG8_WAIT_L(8); PG8_BAR; PG8_WAIT_L(0); PG8_MMA(0, 0, At, B0); PG8_BAR; PG8_SCHED;
            PG8_LDB(B1, 1, 1); PG8_STAGE(PG8_SB(1, 0), b3, voffB);
            PG8_BAR; PG8_WAIT_L(0); PG8_MMA(0, 1, At, B1); PG8_BAR;
            PG8_LDA(At, 1, 1); PG8_STAGE(PG8_SA(1, 0), a3, voffA);
            PG8_BAR; PG8_WAIT_L(0); PG8_MMA(1, 0, At, B0); PG8_BAR; PG8_SCHED;
            PG8_STAGE(PG8_SB(1, 1), b3 + hstep, voffB);
            PG8_WAIT_V(6); PG8_BAR; PG8_MMA(1, 1, At, B1); PG8_BAR;
        }
        E(acc, cur, wr, wc, fr, fq);
        if (!has_next) break;
#pragma unroll
        for (int a = 0; a < 2; ++a)
#pragma unroll
            for (int b = 0; b < 2; ++b)
#pragma unroll
                for (int m = 0; m < 4; ++m)
#pragma unroll
                    for (int n = 0; n < 2; ++n) acc[a][b][m][n] = (f32x4){0.f, 0.f, 0.f, 0.f};
        cur = nxt; cA = nA; cB = nB; ++ui;
    }
    PG8_WAIT_V(0);
    if (wr == 0) PG8_BAR;
    PG8_BAR;
#undef PG8_SA
#undef PG8_SB
#undef PG8_STAGE
#undef PG8_LDA
#undef PG8_LDB
#undef PG8_MMA
#undef PG8_WAIT_V
#undef PG8_WAIT_L
#undef PG8_BAR
#undef PG8_SCHED
}
}

struct EpiZ {
    static constexpr bool PERM = true;
    bf16_t* Z; float* out;
    __device__ __forceinline__ void operator()(const f32x4 (&acc)[2][2][4][2], const pg8::Unit& u, int wr, int wc, int fr, int fq) const {
        const int row0 = u.pm * 256 + wr * 64 + fr, col0 = u.pn * 256 + wc * 32 + 8 * fq;
#pragma unroll
        for (int ai = 0; ai < 2; ++ai)
#pragma unroll
            for (int m = 0; m < 4; ++m) {
                const int row = row0 + ai * 128 + m * 16;
                bf16_t* rowp = Z + (size_t)row * LDZ + col0;
                const bool last = ((row & 63) == 63) && (row >= MP || (row & (SEQ - 1)) == SEQ - 1);
#pragma unroll
                for (int bj = 0; bj < 2; ++bj) {
                    const f32x4 v0 = acc[ai][bj][m][0], v1 = acc[ai][bj][m][1];
                    u32x4 w; w.x = pk_bf16(v0[0], v0[1]); w.y = pk_bf16(v0[2], v0[3]); w.z = pk_bf16(v1[0], v1[1]); w.w = pk_bf16(v1[2], v1[3]);
                    *(u32x4*)(rowp + bj * 128) = w;
                    if (last) {
                        const int c = col0 + bj * 128 - ZC_S;
                        if (c >= 0 && c < NSHIFT) {
                            float* o = row < MP ? out + O_SHP + (size_t)(row >> 13) * NSHIFT + c : out + O_SHS + (size_t)((row - MP) >> 6) * NSHIFT + c;
                            *(f32x4*)o = v0; *(f32x4*)(o + 4) = v1;
                        }
                    }
                }
            }
    }
};
struct EpiY {
    static constexpr bool PERM = true;
    const float *xp, *xs; bf16_t* yb;
    __device__ __forceinline__ void operator()(const f32x4 (&acc)[2][2][4][2], const pg8::Unit& u, int wr, int wc, int fr, int fq) const {
        const int row0 = u.pm * 256 + wr * 64 + fr, col0 = u.pn * 256 + wc * 32 + 8 * fq;
#pragma unroll
        for (int ai = 0; ai < 2; ++ai)
#pragma unroll
            for (int m = 0; m < 4; ++m) {
                const int row = row0 + ai * 128 + m * 16;
                bf16_t* orow = yb + (size_t)row * DM + col0;
#pragma unroll
                for (int bj = 0; bj < 2; ++bj) {
                    const f32x4 v0 = acc[ai][bj][m][0], v1 = acc[ai][bj][m][1];
                    *(u32x4*)(orow + bj * 128) = (u32x4){pk_bf16(v0[0], v0[1]), pk_bf16(v0[2], v0[3]), pk_bf16(v1[0], v1[1]), pk_bf16(v1[2], v1[3])};
                }
            }
    }
};

__device__ __forceinline__ void phase_convert(const Params& p, unsigned char* shm) {
    const int tid = threadIdx.x, lane = tid & 63, wid = tid >> 6;
    for (int row = blockIdx.x * 8 + wid; row < MT; row += gridDim.x * 8) {
        const float* xr = xrow(p, row);
        f32x4 v[8]; float ss = 0.f;
#pragma unroll
        for (int i = 0; i < 8; ++i) { v[i] = *(const f32x4*)(xr + i * 256 + lane * 4); ss += v[i][0] * v[i][0] + v[i][1] * v[i][1] + v[i][2] * v[i][2] + v[i][3] * v[i][3]; }
        ss = wave_sum(ss);
        const float rs = rsqrtf(ss * (1.0f / DM) + 1e-6f);
        bf16_t* o = p.XB + (size_t)row * DM;
#pragma unroll
        for (int i = 0; i < 8; ++i) { u32x2 w; w.x = pk_bf16(v[i][0] * rs, v[i][1] * rs); w.y = pk_bf16(v[i][2] * rs, v[i][3] * rs); *(u32x2*)(o + i * 256 + lane * 4) = w; }
    }
    float* tw = (float*)shm + wid * (64 * 65);
    constexpr int NT_IN = 32 * (LDZ / 64), NT_OUT = 32 * 32;
    for (int tile = blockIdx.x * 8 + wid; tile < NT_IN + NT_OUT; tile += gridDim.x * 8) {
        const bool is_in = tile < NT_IN; const int tl = is_in ? tile : tile - NT_IN;
        const int kt = tl & 31, ntile = tl >> 5, k0 = kt * 64, n0 = ntile * 64;
        const int N = is_in ? DPROJ : DM; const float* w = is_in ? p.w_in : p.w_out; bf16_t* wt = is_in ? p.WTI : p.WTO;
        const bool valid = n0 < N;
        const int rr = lane >> 4, c4 = (lane & 15) * 4;
        f32x4 v[16]; float gsc[16];
#pragma unroll
        for (int i = 0; i < 16; ++i) { const int r = 4 * i + rr; const size_t o = valid ? (size_t)(k0 + r) * N + n0 + c4 : 0; v[i] = *(const f32x4*)(w + o); gsc[i] = p.norm_g[k0 + r]; }
#pragma unroll
        for (int i = 0; i < 16; ++i) { const int r = 4 * i + rr; const float sc = valid ? (is_in ? gsc[i] : 1.0f) : 0.0f; const f32x4 x = v[i] * sc;
            tw[r * 65 + c4] = x[0]; tw[r * 65 + c4 + 1] = x[1]; tw[r * 65 + c4 + 2] = x[2]; tw[r * 65 + c4 + 3] = x[3]; }
        asm volatile("s_waitcnt lgkmcnt(0)" ::: "memory"); __builtin_amdgcn_wave_barrier();
        const int k8 = (lane & 7) * 8;
#pragma unroll
        for (int ps = 0; ps < 8; ++ps) { const int n = ps * 8 + (lane >> 3); float f[8];
#pragma unroll
            for (int j = 0; j < 8; ++j) f[j] = tw[(k8 + j) * 65 + n];
            u32x4 o; o.x = pk_bf16(f[0], f[1]); o.y = pk_bf16(f[2], f[3]); o.z = pk_bf16(f[4], f[5]); o.w = pk_bf16(f[6], f[7]);
            *(u32x4*)(wt + (size_t)(n0 + n) * DM + k0 + k8) = o; }
        asm volatile("s_waitcnt lgkmcnt(0)" ::: "memory"); __builtin_amdgcn_wave_barrier();
    }
}

__device__ __forceinline__ f32x4 ld_bf4(const bf16_t* p) { const u32x2 u = *(const u32x2*)p; return (f32x4){bf_lo(u.x), bf_hi(u.x), bf_lo(u.y), bf_hi(u.y)}; }
__device__ __forceinline__ void st_bf4(bf16_t* p, f32x4 v) { u32x2 u; u.x = pk_bf16(v[0], v[1]); u.y = pk_bf16(v[2], v[3]); *(u32x2*)p = u; }
__device__ __forceinline__ f32x4 zs_prev4(const Params& p, int row, int c) {
    const int prow = row > 0 ? row - 1 : 0, sb = row >= MP ? (row - MP) >> 6 : 0;
    const f32x4 zp = ld_bf4(p.Z + (size_t)prow * LDZ + ZC_S + c), sp = *(const f32x4*)(p.st_shift + (size_t)sb * NSHIFT + c);
    const bool first = seq_first(row), samp = row >= MP;
    f32x4 r;
#pragma unroll
    for (int e = 0; e < 4; ++e) r[e] = first ? (samp ? sp[e] : 0.f) : zp[e];
    return r;
}
#define LDS_BARRIER() do { asm volatile("s_waitcnt lgkmcnt(0)" ::: "memory"); __builtin_amdgcn_s_barrier(); asm volatile("" ::: "memory"); } while (0)
#define MFMA16(a, b, c) __builtin_amdgcn_mfma_f32_16x16x32_bf16(a, b, c, 0, 0, 0)
__device__ __forceinline__ bf16x8 ldfrag(const bf16_t* X, int ld, int row0, int k0, int fr, int fq) { return *(const bf16x8*)(X + (size_t)(row0 + fr) * ld + k0 + 8 * fq); }
__device__ __forceinline__ f32x4 up_bf4(u32x2 u) { return (f32x4){bf_lo(u.x), bf_hi(u.x), bf_lo(u.y), bf_hi(u.y)}; }
__device__ __forceinline__ u32x2 pk_bf4(f32x4 v) { u32x2 u; u.x = pk_bf16(v[0], v[1]); u.y = pk_bf16(v[2], v[3]); return u; }
constexpr int NCH = MT / 64;

__device__ __forceinline__ bf16x8 cvt_frag8(const float* s) {
    const f32x4 a = *(const f32x4*)s, b = *(const f32x4*)(s + 4);
    const u32x4 u = (u32x4){pk_bf16(a[0], a[1]), pk_bf16(a[2], a[3]), pk_bf16(b[0], b[1]), pk_bf16(b[2], b[3])};
    return __builtin_bit_cast(bf16x8, u);
}
#define WAVE_SYNC() do { asm volatile("s_waitcnt lgkmcnt(0)" ::: "memory"); __builtin_amdgcn_wave_barrier(); } while (0)
__device__ __forceinline__ void tinv_wave(const float* Aab, bf16_t* Tm, bf16_t* TT, bf16_t* ET, bf16_t* E2T, int lane) {
    constexpr int LD = 72;
    const int fr = lane & 15, fq = lane >> 4;
    const bf16x8 zf = (bf16x8){0, 0, 0, 0, 0, 0, 0, 0};
    {
        const u32x4 z = (u32x4){0u, 0u, 0u, 0u};
#pragma unroll
        for (int i = 0; i < 9; ++i) { *(u32x4*)(Tm + lane * LD + i * 8) = z; *(u32x4*)(TT + lane * LD + i * 8) = z; }
    }
    WAVE_SYNC();
    {
        const int q = fq, c = fr; const float* Ab = Aab + (16 * q) * 68 + 16 * q;
        float d[16];
#pragma unroll
        for (int i = 0; i < 16; ++i) {
            float a = (i == c) ? 1.0f : 0.0f;
#pragma unroll
            for (int m = 0; m < i; ++m) a -= Ab[i * 68 + m] * d[m];
            d[i] = a;
            if ((i & 3) == 3) __builtin_amdgcn_sched_barrier(0);
        }
        u32x4 lo, hi;
        lo.x = pk_bf16(d[0], d[1]); lo.y = pk_bf16(d[2], d[3]); lo.z = pk_bf16(d[4], d[5]); lo.w = pk_bf16(d[6], d[7]);
        hi.x = pk_bf16(d[8], d[9]); hi.y = pk_bf16(d[10], d[11]); hi.z = pk_bf16(d[12], d[13]); hi.w = pk_bf16(d[14], d[15]);
        *(u32x4*)(TT + (16 * q + c) * LD + 16 * q) = lo; *(u32x4*)(TT + (16 * q + c) * LD + 16 * q + 8) = hi;
#pragma unroll
        for (int i = 0; i < 16; ++i) Tm[(16 * q + i) * LD + 16 * q + c] = f2bf(d[i]);
    }
    WAVE_SYNC();
    LDS_BARRIER();
#pragma unroll
    for (int P = 0; P < 2; ++P) {
        const int lo = 2 * P, hi = 2 * P + 1;
        const bf16x8 a = fq < 2 ? cvt_frag8(Aab + (16 * hi + fr) * 68 + 16 * lo + 8 * fq) : zf;
        const bf16x8 b = fq < 2 ? *(const bf16x8*)(TT + (16 * lo + fr) * LD + 16 * lo + 8 * fq) : zf;
        const f32x4 e = MFMA16(a, b, ((f32x4){0.f, 0.f, 0.f, 0.f}));
        st_bf4(ET + (P * 16 + fr) * 24 + 4 * fq, e);
    }
    WAVE_SYNC();
#pragma unroll
    for (int P = 0; P < 2; ++P) {
        const int lo = 2 * P, hi = 2 * P + 1;
        const bf16x8 a = fq < 2 ? *(const bf16x8*)(Tm + (16 * hi + fr) * LD + 16 * hi + 8 * fq) : zf;
        const bf16x8 b = fq < 2 ? *(const bf16x8*)(ET + (P * 16 + fr) * 24 + 8 * fq) : zf;
        const f32x4 t = -MFMA16(a, b, ((f32x4){0.f, 0.f, 0.f, 0.f}));
        st_bf4(TT + (16 * lo + fr) * LD + 16 * hi + 4 * fq, t);
#pragma unroll
        for (int j = 0; j < 4; ++j) Tm[(16 * hi + 4 * fq + j) * LD + 16 * lo + fr] = f2bf(t[j]);
    }
    WAVE_SYNC();
#pragma unroll
    for (int mi = 0; mi < 2; ++mi) {
        const bf16x8 a = cvt_frag8(Aab + (32 + 16 * mi + fr) * 68 + 8 * fq);
#pragma unroll
        for (int nc = 0; nc < 2; ++nc) {
            const bf16x8 b = *(const bf16x8*)(TT + (16 * nc + fr) * LD + 8 * fq);
            const f32x4 e = MFMA16(a, b, ((f32x4){0.f, 0.f, 0.f, 0.f}));
            st_bf4(E2T + (16 * nc + fr) * 40 + 16 * mi + 4 * fq, e);
        }
    }
    WAVE_SYNC();
#pragma unroll
    for (int mi = 0; mi < 2; ++mi) {
        const bf16x8 a = *(const bf16x8*)(Tm + (32 + 16 * mi + fr) * LD + 32 + 8 * fq);
#pragma unroll
        for (int nc = 0; nc < 2; ++nc) {
            const bf16x8 b = *(const bf16x8*)(E2T + (16 * nc + fr) * 40 + 8 * fq);
            const f32x4 t = -MFMA16(a, b, ((f32x4){0.f, 0.f, 0.f, 0.f}));
#pragma unroll
            for (int j = 0; j < 4; ++j) Tm[(32 + 16 * mi + 4 * fq + j) * LD + 16 * nc + fr] = f2bf(t[j]);
        }
    }
    LDS_BARRIER();
}

__device__ __forceinline__ void phase_prep(const Params& p, unsigned char* shm) {
    constexpr int LD = 72, LZH = 136, LZS = 200;
    bf16_t* thw = (bf16_t*)shm; bf16_t* tha = thw + 64 * LD; bf16_t* w2T = tha + 64 * LD; bf16_t* a2T = w2T + 64 * LD;
    float* Aab = (float*)shm;
    bf16_t* Tm = (bf16_t*)(shm + 17408); bf16_t* VKt = Tm + 64 * LD;
    bf16_t* Qt = (bf16_t*)(shm + 36864); bf16_t* Kt = Qt + 64 * LD; bf16_t* Bt = Kt + 64 * LD; bf16_t* KKt = Bt + 64 * LD;
    bf16_t* zh = Qt;
    bf16_t* zs = (bf16_t*)(shm + 36864 + 65 * LZH * 2);
    bf16_t* XT = KKt;
    bf16_t* TT = (bf16_t*)(shm + 152064); bf16_t* ET = TT + 64 * LD; bf16_t* E2T = ET;
    bf16_t* KKtT = (bf16_t*)(shm + 73728); bf16_t* VmT = KKtT + 64 * LD; bf16_t* KpT = VmT + 64 * LD; bf16_t* BpT = KpT + 64 * LD;
    bf16_t* YVt = KpT; bf16_t* W1t = BpT; bf16_t* U0t = VmT;
    bf16_t* Aak = (bf16_t*)(shm + 110592); bf16_t* Aqk = Aak + 64 * LD;
    float* red = (float*)Aak; float* tot = red + 256;
    bf16_t* w2P = (bf16_t*)(shm + 131072); bf16_t* a2P = w2P + 64 * LD;
    float* prm = (float*)(shm + 131072 + 18432);
    {
        const int tid0 = threadIdx.x, hh = blockIdx.x & 15;
#pragma unroll
        for (int i = 0; i < 4; ++i) { const int pc = tid0 + 512 * i, mat = pc >> 10, ii = (pc >> 4) & 63, s4 = pc & 15;
            const f32x4 w = *(const f32x4*)((mat ? p.a2 : p.w2) + (size_t)ii * 1024 + hh * 64 + 4 * s4); bf16_t* d = (mat ? a2P : w2P) + (4 * s4) * LD + ii;
            d[0] = f2bf(w[0]); d[LD] = f2bf(w[1]); d[2 * LD] = f2bf(w[2]); d[3 * LD] = f2bf(w[3]); }
        if (tid0 < 64) { const int c = hh * 64 + tid0;
            prm[tid0] = p.w0[c]; prm[64 + tid0] = p.a0[c]; prm[128 + tid0] = p.mu[c]; prm[192 + tid0] = p.mu[1024 + c]; prm[256 + tid0] = p.mu[2048 + c];
            prm[320 + tid0] = p.k_k[c]; prm[384 + tid0] = p.k_a[c]; prm[448 + tid0] = p.r_k[c]; prm[512 + tid0] = p.mu[3072 + tid0]; prm[576 + tid0] = p.mu[3136 + tid0]; }
    }
    u32x4 zpre[6]; int zcol[6], zrow[6], zlds[6];
    {
        const int t0 = threadIdx.x, hh0 = blockIdx.x & 15;
#pragma unroll
        for (int i = 0; i < 6; ++i) { int pc = t0 + 512 * i; const bool ok = pc < 2600; pc = ok ? pc : 2599;
            const bool isH = pc < 1040; const int q = isH ? pc : pc - 1040, r = isH ? q >> 4 : q / 24, rem = isH ? q & 15 : q % 24;
            zcol[i] = isH ? 3072 + 8 * rem : (rem >> 3) * 1024 + hh0 * 64 + 8 * (rem & 7); zrow[i] = r;
            zlds[i] = ok ? (isH ? 36864 + (r * LZH + 8 * rem) * 2 : 36864 + 65 * LZH * 2 + (r * LZS + (rem >> 3) * 64 + 8 * (rem & 7)) * 2) : -1; }
    }
    auto zload = [&](int it) {
        const int rw0 = (it >> 4) * 64;
#pragma unroll
        for (int i = 0; i < 6; ++i) { int grow = rw0 - 1 + zrow[i]; grow = grow < 0 ? 0 : grow; zpre[i] = *(const u32x4*)(p.Z + (size_t)grow * LDZ + ZC_S + zcol[i]); }
    };
    if ((int)blockIdx.x < NCH * 16) zload(blockIdx.x);
    for (int item = blockIdx.x; item < NCH * 16; item += gridDim.x) {
        int tid = threadIdx.x; asm volatile("" : "+v"(tid));
        const int lane = tid & 63, wid = __builtin_amdgcn_readfirstlane(tid >> 6), fr = lane & 15, fq = lane >> 4;
        const int h = item & 15, cidx = item >> 4, row0 = cidx * 64; const size_t chbase = (size_t)item * 4096;
        const int crow = tid >> 3, cseg = (tid & 7) * 8;
        {
            const bool first = seq_first(row0);
#pragma unroll
            for (int i = 0; i < 6; ++i) {
                if (zlds[i] >= 0) {
                    u32x4 v = zpre[i];
                    if (first && zrow[i] == 0) { v = (u32x4){0u, 0u, 0u, 0u};
                        if (row0 >= MP) { const float* sp = p.st_shift + (size_t)((row0 - MP) >> 6) * NSHIFT + zcol[i]; const f32x4 a = *(const f32x4*)sp, b = *(const f32x4*)(sp + 4);
                            v = (u32x4){pk_bf16(a[0], a[1]), pk_bf16(a[2], a[3]), pk_bf16(b[0], b[1]), pk_bf16(b[2], b[3])}; } }
                    *(u32x4*)(shm + zlds[i]) = v; } }
            const int nitem = item + (int)gridDim.x;
            zload(nitem < NCH * 16 ? nitem : item);
        }
        LDS_BARRIER();
        {
            const int j = tid >> 3, p8 = tid & 7;
#pragma unroll
            for (int isa = 0; isa < 2; ++isa) {
                const int c = isa * 64 + 8 * p8;
                const u32x4 cu = *(const u32x4*)(zh + (j + 1) * LZH + c), pu = *(const u32x4*)(zh + j * LZH + c);
                const f32x4 m0 = *(const f32x4*)(prm + 512 + c), m1 = *(const f32x4*)(prm + 512 + c + 4);
                const unsigned cw[4] = {cu.x, cu.y, cu.z, cu.w}, pw[4] = {pu.x, pu.y, pu.z, pu.w};
                float x[8];
#pragma unroll
                for (int e = 0; e < 4; ++e) { const float c0 = bf_lo(cw[e]), c1 = bf_hi(cw[e]), mA = e < 2 ? m0[2 * e] : m1[2 * e - 4], mB = e < 2 ? m0[2 * e + 1] : m1[2 * e - 3];
                    x[2 * e] = c0 + mA * (bf_lo(pw[e]) - c0); x[2 * e + 1] = c1 + mB * (bf_hi(pw[e]) - c1); }
                if (isa == 0) {
#pragma unroll
                    for (int e = 0; e < 8; ++e) x[e] = tanh_f(x[e]);
                }
                *(u32x4*)((isa ? tha : thw) + j * LD + 8 * p8) = (u32x4){pk_bf16(x[0], x[1]), pk_bf16(x[2], x[3]), pk_bf16(x[4], x[5]), pk_bf16(x[6], x[7])};
            }
            {
                const u32x4 cu = *(const u32x4*)(zs + (j + 1) * LZS + 128 + 8 * p8), pu = *(const u32x4*)(zs + j * LZS + 128 + 8 * p8);
                const f32x4 m0 = *(const f32x4*)(prm + 256 + 8 * p8), m1 = *(const f32x4*)(prm + 256 + 8 * p8 + 4);
                const unsigned cw[4] = {cu.x, cu.y, cu.z, cu.w}, pw[4] = {pu.x, pu.y, pu.z, pu.w};
                float x[8];
#pragma unroll
                for (int e = 0; e < 4; ++e) { const float c0 = bf_lo(cw[e]), c1 = bf_hi(cw[e]), mA = e < 2 ? m0[2 * e] : m1[2 * e - 4], mB = e < 2 ? m0[2 * e + 1] : m1[2 * e - 3];
                    x[2 * e] = c0 + mA * (bf_lo(pw[e]) - c0); x[2 * e + 1] = c1 + mB * (bf_hi(pw[e]) - c1); }
                *(u32x4*)(p.PV + ((size_t)(row0 + j) * 16 + h) * 64 + 8 * p8) = (u32x4){pk_bf16(x[0], x[1]), pk_bf16(x[2], x[3]), pk_bf16(x[4], x[5]), pk_bf16(x[6], x[7])};
            }
        }
        LDS_BARRIER();
        const int tt = wid & 3, chh = wid >> 2, tk = 16 * tt + fr, row = row0 + tk;
        f32x4 lw[2], av[2], vm[2], kkv[2], kp[2], rm[2], cs[2]; float nrm = 0.f, rk = 0.f;
        {
            f32x4 accd[2], acca[2];
#pragma unroll
            for (int n = 0; n < 2; ++n) { accd[n] = (f32x4){0.f, 0.f, 0.f, 0.f}; acca[n] = (f32x4){0.f, 0.f, 0.f, 0.f}; }
#pragma unroll
            for (int ks = 0; ks < 2; ++ks) {
                const bf16x8 bw = ldfrag(thw, LD, 16 * tt, 32 * ks, fr, fq), ba = ldfrag(tha, LD, 16 * tt, 32 * ks, fr, fq);
#pragma unroll
                for (int n = 0; n < 2; ++n) {
                    accd[n] = MFMA16(ldfrag(w2P, LD, 32 * chh + 16 * n, 32 * ks, fr, fq), bw, accd[n]);
                    acca[n] = MFMA16(ldfrag(a2P, LD, 32 * chh + 16 * n, 32 * ks, fr, fq), ba, acca[n]);
                }
            }
            const bf16_t* zc = zs + (tk + 1) * LZS; const bf16_t* zp = zs + tk * LZS;
#pragma unroll
            for (int n = 0; n < 2; ++n) {
                const int c4 = 32 * chh + 16 * n + 4 * fq;
                const f32x4 d = *(const f32x4*)(prm + c4) + accd[n], al = *(const f32x4*)(prm + 64 + c4) + acca[n];
#pragma unroll
                for (int j = 0; j < 4; ++j) { lw[n][j] = -0.87503886f * sigmoid_f(d[j]); av[n][j] = sigmoid_f(al[j]); }
                { const f32x4 vc = ld_bf4(zc + 128 + c4), vp = ld_bf4(zp + 128 + c4); vm[n] = vc + *(const f32x4*)(prm + 256 + c4) * (vp - vc); }
                const f32x4 kc = ld_bf4(zc + 64 + c4), kpv = ld_bf4(zp + 64 + c4);
                const f32x4 k = kc + *(const f32x4*)(prm + 192 + c4) * (kpv - kc);
                kkv[n] = k * *(const f32x4*)(prm + 320 + c4);
                kp[n] = k * (1.0f + (av[n] - 1.0f) * *(const f32x4*)(prm + 384 + c4));
                const f32x4 rc = ld_bf4(zc + c4), rp = ld_bf4(zp + c4);
                rm[n] = rc + *(const f32x4*)(prm + 128 + c4) * (rp - rc);
                const f32x4 rkw = rm[n] * kp[n] * *(const f32x4*)(prm + 448 + c4);
                nrm += kkv[n][0] * kkv[n][0] + kkv[n][1] * kkv[n][1] + kkv[n][2] * kkv[n][2] + kkv[n][3] * kkv[n][3];
                rk += rkw[0] + rkw[1] + rkw[2] + rkw[3];
#pragma unroll
                for (int j = 0; j < 4; ++j) {
                    float x = lw[n][j];
                    x += __int_as_float(__builtin_amdgcn_update_dpp(0, __float_as_int(x), 0x111, 0xf, 0xf, false));
                    x += __int_as_float(__builtin_amdgcn_update_dpp(0, __float_as_int(x), 0x112, 0xf, 0xf, false));
                    x += __int_as_float(__builtin_amdgcn_update_dpp(0, __float_as_int(x), 0x114, 0xf, 0xf, false));
                    x += __int_as_float(__builtin_amdgcn_update_dpp(0, __float_as_int(x), 0x118, 0xf, 0xf, false));
                    cs[n][j] = x;
                }
                if (fr == 15) *(f32x4*)(tot + tt * 64 + c4) = cs[n];
            }
            nrm += __shfl_xor(nrm, 16); nrm += __shfl_xor(nrm, 32);
            rk += __shfl_xor(rk, 16); rk += __shfl_xor(rk, 32);
            if (fq == 0) { red[wid * 16 + fr] = nrm; red[128 + wid * 16 + fr] = rk; }
        }
        LDS_BARRIER();
        {
            nrm += red[(wid ^ 4) * 16 + fr]; rk += red[128 + (wid ^ 4) * 16 + fr];
            const float inv = 1.0f / fmaxf(sqrtf(nrm), 1e-12f);
            p.PRK[(size_t)row * 16 + h] = rk;
#pragma unroll
            for (int n = 0; n < 2; ++n) {
                const int c4 = 32 * chh + 16 * n + 4 * fq;
                f32x4 pre = (f32x4){0.f, 0.f, 0.f, 0.f}, total = (f32x4){0.f, 0.f, 0.f, 0.f};
#pragma unroll
                for (int t2 = 0; t2 < 4; ++t2) { const f32x4 x = *(const f32x4*)(tot + t2 * 64 + c4); total += x; if (t2 < tt) pre += x; }
                const f32x4 csum = pre + cs[n];
                f32x4 eg, eng, egm, etc;
#pragma unroll
                for (int j = 0; j < 4; ++j) { eg[j] = __builtin_amdgcn_exp2f(csum[j]); eng[j] = __builtin_amdgcn_exp2f(-csum[j]); egm[j] = __builtin_amdgcn_exp2f(csum[j] - lw[n][j]); etc[j] = __builtin_amdgcn_exp2f(total[j] - csum[j]); }
                const f32x4 kkn = kkv[n] * inv, bb = kkn * av[n];
                const f32x4 qt = rm[n] * eg, kt = kp[n] * eng, bt = bb * eng, kkt = kkn * egm, kpp = kp[n] * etc, bpp = bb * etc;
                st_bf4(Qt + tk * LD + c4, qt); st_bf4(Kt + tk * LD + c4, kt); st_bf4(Bt + tk * LD + c4, bt); st_bf4(KKt + tk * LD + c4, kkt);
#pragma unroll
                for (int e = 0; e < 4; ++e) {
                    KKtT[(c4 + e) * LD + tk] = f2bf(kkt[e]); VmT[(c4 + e) * LD + tk] = f2bf(vm[n][e]); KpT[(c4 + e) * LD + tk] = f2bf(kpp[e]); BpT[(c4 + e) * LD + tk] = f2bf(bpp[e]);
                }
                if (tt == 0) { f32x4 g; g[0] = __builtin_amdgcn_exp2f(total[0]); g[1] = __builtin_amdgcn_exp2f(total[1]); g[2] = __builtin_amdgcn_exp2f(total[2]); g[3] = __builtin_amdgcn_exp2f(total[3]); *(f32x4*)(p.GCG + (size_t)item * 64 + c4) = g; }
            }
        }
        LDS_BARRIER();
        {
            const int nt = wid & 3; const bf16x8 b0 = ldfrag(KKt, LD, 16 * nt, 0, fr, fq), b1 = ldfrag(KKt, LD, 16 * nt, 32, fr, fq);
#pragma unroll
            for (int q = 0; q < 2; ++q) {
                const int ms = 2 * (wid >> 2) + q; f32x4 c1 = (f32x4){0.f, 0.f, 0.f, 0.f};
                if (ms <= nt) {
                    c1 = MFMA16(ldfrag(Bt, LD, 16 * ms, 0, fr, fq), b0, c1); c1 = MFMA16(ldfrag(Bt, LD, 16 * ms, 32, fr, fq), b1, c1);
                    if (ms == nt) {
#pragma unroll
                        for (int j = 0; j < 4; ++j) if (4 * fq + j >= fr) c1[j] = 0.f;
                    }
                }
                *(f32x4*)(Aab + (16 * nt + fr) * 68 + 16 * ms + 4 * fq) = c1;
            }
        }
        LDS_BARRIER();
        if (wid == 7) {
            tinv_wave(Aab, Tm, TT, ET, E2T, lane);
        } else {
            for (int pc = tid; pc < 1024; pc += 448) { const int r = (pc & 511) >> 3, sg = (pc & 7) * 8;
                if (pc < 512) *(u32x4*)(p.QG + chbase + r * 64 + sg) = *(const u32x4*)(Qt + r * LD + sg); else *(u32x4*)(p.BPG + chbase + r * 64 + sg) = *(const u32x4*)(BpT + r * LD + sg); }
            for (int idx = wid; idx < 64; idx += 7) {
                const int mat = idx >> 4, nt = (idx >> 2) & 3, ms = idx & 3;
                f32x4 c = (f32x4){0.f, 0.f, 0.f, 0.f};
                if (mat == 3) {
                    c = MFMA16(ldfrag(KpT, LD, 16 * nt, 0, fr, fq), ldfrag(VmT, LD, 16 * ms, 0, fr, fq), c);
                    c = MFMA16(ldfrag(KpT, LD, 16 * nt, 32, fr, fq), ldfrag(VmT, LD, 16 * ms, 32, fr, fq), c);
                    st_bf4(VKt + (16 * ms + fr) * LD + 16 * nt + 4 * fq, c);
                } else {
                    const bf16_t* asrc = mat == 2 ? Bt : Kt; const bf16_t* bsrc = mat == 0 ? KKt : Qt;
                    if (ms <= nt) {
                        c = MFMA16(ldfrag(asrc, LD, 16 * ms, 0, fr, fq), ldfrag(bsrc, LD, 16 * nt, 0, fr, fq), c);
                        c = MFMA16(ldfrag(asrc, LD, 16 * ms, 32, fr, fq), ldfrag(bsrc, LD, 16 * nt, 32, fr, fq), c);
                        if (ms == nt) {
#pragma unroll
                            for (int j = 0; j < 4; ++j) { const int sx = 4 * fq + j; const bool keep = mat ? (sx <= fr) : (sx < fr); if (!keep) c[j] = 0.f; }
                        }
                    }
                    const int tix = 16 * nt + fr, six = 16 * ms + 4 * fq;
                    if (mat == 0) st_bf4(Aak + tix * LD + six, c); else if (mat == 1) st_bf4(Aqk + tix * LD + six, c); else st_bf4(p.AQBG + chbase + tix * 64 + six, c);
                }
            }
            LDS_BARRIER();
            for (int idx = wid; idx < 32; idx += 7) {
                f32x4 c = (f32x4){0.f, 0.f, 0.f, 0.f};
                if (idx < 16) { const int mt = idx >> 2, nv = idx & 3;
                    c = MFMA16(ldfrag(Aak, LD, 16 * mt, 0, fr, fq), ldfrag(VmT, LD, 16 * nv, 0, fr, fq), c);
                    c = MFMA16(ldfrag(Aak, LD, 16 * mt, 32, fr, fq), ldfrag(VmT, LD, 16 * nv, 32, fr, fq), c);
                    st_bf4(XT + (16 * nv + fr) * LD + 16 * mt + 4 * fq, c);
                } else { const int i2 = idx - 16, mv = i2 >> 2, nt = i2 & 3;
                    c = MFMA16(ldfrag(VmT, LD, 16 * mv, 0, fr, fq), ldfrag(Aqk, LD, 16 * nt, 0, fr, fq), c);
                    c = MFMA16(ldfrag(VmT, LD, 16 * mv, 32, fr, fq), ldfrag(Aqk, LD, 16 * nt, 32, fr, fq), c);
                    st_bf4(YVt + (16 * nt + fr) * LD + 16 * mv + 4 * fq, c);
                }
            }
            LDS_BARRIER();
        }
        {
            *(u32x4*)(p.VKG + chbase + crow * 64 + cseg) = *(const u32x4*)(VKt + crow * LD + cseg);
            *(u32x4*)(p.YVG + chbase + crow * 64 + cseg) = *(const u32x4*)(YVt + crow * LD + cseg);
#pragma unroll
            for (int i = 0; i < 4; ++i) {
                const int idx = wid + 8 * i; f32x4 c = (f32x4){0.f, 0.f, 0.f, 0.f};
                if (idx < 16) { const int mk = idx >> 2, nt = idx & 3;
                    c = MFMA16(ldfrag(KKtT, LD, 16 * mk, 0, fr, fq), ldfrag(Tm, LD, 16 * nt, 0, fr, fq), c);
                    c = MFMA16(ldfrag(KKtT, LD, 16 * mk, 32, fr, fq), ldfrag(Tm, LD, 16 * nt, 32, fr, fq), c);
                    st_bf4(W1t + (16 * nt + fr) * LD + 16 * mk + 4 * fq, -c);
                } else { const int i2 = idx - 16, mt = i2 >> 2, nv = i2 & 3;
                    c = MFMA16(ldfrag(Tm, LD, 16 * mt, 0, fr, fq), ldfrag(XT, LD, 16 * nv, 0, fr, fq), c);
                    c = MFMA16(ldfrag(Tm, LD, 16 * mt, 32, fr, fq), ldfrag(XT, LD, 16 * nv, 32, fr, fq), c);
                    st_bf4(U0t + (16 * nv + fr) * LD + 16 * mt + 4 * fq, -c);
                }
            }
        }
        LDS_BARRIER();
        *(u32x4*)(p.W1G + chbase + crow * 64 + cseg) = *(const u32x4*)(W1t + crow * LD + cseg);
        *(u32x4*)(p.U0G + chbase + crow * 64 + cseg) = *(const u32x4*)(U0t + crow * LD + cseg);
    }
}

__device__ __forceinline__ void seq_item(const Params& p, unsigned char* shm, int row0, int nchunks, int h, const float* S0, float* Sout) {
    constexpr int LD = 72, SLOT = 4 * 64 * LD + 128;
    bf16_t* Sb = (bf16_t*)shm; bf16_t* UT = Sb + 64 * LD; bf16_t* ring = UT + 64 * LD;
    const int tid = threadIdx.x, lane = tid & 63, wid = tid >> 6, fr = lane & 15, fq = lane >> 4;
    const int m = wid >> 1, nv0 = 2 * (wid & 1), c0 = 16 * m + 4 * fq;
    const int crow = tid >> 3, cseg = (tid & 7) * 8;
    f32x4 S[2];
#pragma unroll
    for (int q = 0; q < 2; ++q) S[q] = S0 ? *(const f32x4*)(S0 + (16 * (nv0 + q) + fr) * 64 + c0) : (f32x4){0.f, 0.f, 0.f, 0.f};
    const int chi0 = (row0 >> 6) * 16 + h, last = nchunks - 1;
    struct Stage { u32x4 g[4]; f32x4 gc; };
    auto gload = [&](int ci, Stage& G) {
        const size_t cb = (size_t)(chi0 + ci * 16) * 4096 + crow * 64 + cseg;
        G.g[0] = *(const u32x4*)(p.W1G + cb); G.g[1] = *(const u32x4*)(p.BPG + cb); G.g[2] = *(const u32x4*)(p.U0G + cb); G.g[3] = *(const u32x4*)(p.VKG + cb);
        G.gc = *(const f32x4*)(p.GCG + (size_t)(chi0 + ci * 16) * 64 + (tid & 15) * 4);
    };
    auto park = [&](int slot, const Stage& G) {
        bf16_t* d = ring + slot * SLOT;
#pragma unroll
        for (int a = 0; a < 4; ++a) *(u32x4*)(d + a * 64 * LD + crow * LD + cseg) = G.g[a];
        if (tid < 16) *(f32x4*)((float*)(d + 4 * 64 * LD) + tid * 4) = G.gc;
    };
    auto body = [&](int ci, int slot, int pslot, const Stage& G) {
        const bf16_t* W1s = ring + slot * SLOT; const bf16_t* BPs = W1s + 64 * LD; const bf16_t* U0s = BPs + 64 * LD; const bf16_t* VKs = U0s + 64 * LD;
        const float* GCs = (const float*)(VKs + 64 * LD);
        const size_t cb = (size_t)(chi0 + ci * 16) * 4096;
#pragma unroll
        for (int q = 0; q < 2; ++q) *(u32x2*)(Sb + (16 * (nv0 + q) + fr) * LD + c0) = pk_bf4(S[q]);
        LDS_BARRIER();
        park(pslot, G);
        *(u32x4*)(p.Z + (size_t)(row0 + ci * 64 + crow) * LDZ + ZC_S + h * 64 + cseg) = *(const u32x4*)(Sb + crow * LD + cseg);
        const bf16x8 w10 = ldfrag(W1s, LD, 16 * m, 0, fr, fq), w11 = ldfrag(W1s, LD, 16 * m, 32, fr, fq);
#pragma unroll
        for (int q = 0; q < 2; ++q) {
            const int v = 16 * (nv0 + q) + fr;
            f32x4 acc = up_bf4(*(const u32x2*)(U0s + v * LD + c0));
            acc = MFMA16(w10, ldfrag(Sb, LD, 16 * (nv0 + q), 0, fr, fq), acc);
            acc = MFMA16(w11, ldfrag(Sb, LD, 16 * (nv0 + q), 32, fr, fq), acc);
            *(u32x2*)(UT + v * LD + c0) = pk_bf4(acc);
        }
        LDS_BARRIER();
        *(u32x4*)(p.UTG + cb + crow * 64 + cseg) = *(const u32x4*)(UT + crow * LD + cseg);
        const bf16x8 bp0 = ldfrag(BPs, LD, 16 * m, 0, fr, fq), bp1 = ldfrag(BPs, LD, 16 * m, 32, fr, fq);
        const f32x4 gc = *(const f32x4*)(GCs + c0);
#pragma unroll
        for (int q = 0; q < 2; ++q) {
            const int v = 16 * (nv0 + q) + fr;
            f32x4 acc = S[q] * gc + up_bf4(*(const u32x2*)(VKs + v * LD + c0));
            acc = MFMA16(bp0, ldfrag(UT, LD, 16 * (nv0 + q), 0, fr, fq), acc);
            acc = MFMA16(bp1, ldfrag(UT, LD, 16 * (nv0 + q), 32, fr, fq), acc);
            S[q] = acc;
        }
    };
    Stage A, B;
    gload(0, A); gload(min(1, last), B);
    park(0, A); park(1, B);
    gload(min(2, last), A);
    int scur = 0, spark = 2;
    for (int ci = 0; ci < nchunks; ci += 2) {
        gload(min(ci + 3, last), B);
        body(ci, scur, spark, A);
        scur = scur == 2 ? 0 : scur + 1; spark = spark == 2 ? 0 : spark + 1;
        if (ci + 1 >= nchunks) break;
        gload(min(ci + 4, last), A);
        body(ci + 1, scur, spark, B);
        scur = scur == 2 ? 0 : scur + 1; spark = spark == 2 ? 0 : spark + 1;
    }
    LDS_BARRIER();
#pragma unroll
    for (int q = 0; q < 2; ++q) *(f32x4*)(Sout + (16 * (nv0 + q) + fr) * 64 + c0) = S[q];
}

__device__ __forceinline__ void phase_out(const Params& p, unsigned char* shm) {
    constexpr int LD = 72, TILE = 64 * LD, NPAIR = NCH * 8;
    const int tid = threadIdx.x, lane = tid & 63, wid = tid >> 6, fr = lane & 15, fq = lane >> 4;
    const int half = wid >> 2, nt = wid & 3, th = tid & 255, crow = th >> 3, cseg = (th & 7) * 8;
    bf16_t* base = (bf16_t*)shm + half * 7 * TILE;
    bf16_t* SbT = base; bf16_t* UTt = base + TILE; bf16_t* Qt = base + 2 * TILE; bf16_t* AQt = base + 3 * TILE; bf16_t* YVt = base + 4 * TILE; bf16_t* PVt = base + 5 * TILE; bf16_t* GBt = base + 6 * TILE;
    u32x4 g[7][2];
    auto gload = [&](int pr) {
        const int item = 2 * pr + half, h = item & 15, row0 = (item >> 4) * 64; const size_t cb = (size_t)item * 4096;
#pragma unroll
        for (int i = 0; i < 2; ++i) { const int r = crow + 32 * i; const size_t o = cb + r * 64 + cseg;
            g[0][i] = *(const u32x4*)(p.Z + (size_t)(row0 + r) * LDZ + ZC_S + h * 64 + cseg);
            g[1][i] = *(const u32x4*)(p.UTG + o); g[2][i] = *(const u32x4*)(p.QG + o); g[3][i] = *(const u32x4*)(p.AQBG + o); g[4][i] = *(const u32x4*)(p.YVG + o);
            g[5][i] = *(const u32x4*)(p.PV + ((size_t)(row0 + r) * 16 + h) * 64 + cseg);
            g[6][i] = *(const u32x4*)(p.Z + (size_t)(row0 + r) * LDZ + ZC_GB + h * 64 + cseg); }
    };
    if ((int)blockIdx.x < NPAIR) gload(blockIdx.x);
    for (int pr = blockIdx.x; pr < NPAIR; pr += gridDim.x) {
        const int item = 2 * pr + half, h = item & 15, row0 = (item >> 4) * 64;
        const float rk = p.PRK[(size_t)(row0 + 16 * nt + fr) * 16 + h];
        f32x4 gng[4], gnb[4];
#pragma unroll
        for (int mv = 0; mv < 4; ++mv) { gng[mv] = *(const f32x4*)(p.gn_g + h * 64 + 16 * mv + 4 * fq); gnb[mv] = *(const f32x4*)(p.gn_b + h * 64 + 16 * mv + 4 * fq); }
#pragma unroll
        for (int a = 0; a < 7; ++a)
#pragma unroll
            for (int i = 0; i < 2; ++i) *(u32x4*)(base + a * TILE + (crow + 32 * i) * LD + cseg) = g[a][i];
        { const int npr = pr + (int)gridDim.x; gload(npr < NPAIR ? npr : pr); }
        LDS_BARRIER();
        const int trow = 16 * nt + fr;
        f32x4 acc[4];
#pragma unroll
        for (int mv = 0; mv < 4; ++mv) acc[mv] = ld_bf4(YVt + trow * LD + 16 * mv + 4 * fq);
#pragma unroll
        for (int ks = 0; ks < 2; ++ks) {
            const bf16x8 bq = ldfrag(Qt, LD, 16 * nt, 32 * ks, fr, fq), ba = ldfrag(AQt, LD, 16 * nt, 32 * ks, fr, fq);
#pragma unroll
            for (int mv = 0; mv < 4; ++mv) {
                acc[mv] = MFMA16(ldfrag(SbT, LD, 16 * mv, 32 * ks, fr, fq), bq, acc[mv]);
                acc[mv] = MFMA16(ldfrag(UTt, LD, 16 * mv, 32 * ks, fr, fq), ba, acc[mv]);
            }
        }
        float s = 0.f;
#pragma unroll
        for (int mv = 0; mv < 4; ++mv) s += (acc[mv][0] + acc[mv][1]) + (acc[mv][2] + acc[mv][3]);
        s += __shfl_xor(s, 16); s += __shfl_xor(s, 32);
        const float mean = s * (1.0f / 64.0f);
        float q = 0.f;
#pragma unroll
        for (int mv = 0; mv < 4; ++mv) { const f32x4 d = acc[mv] - mean; q += (d[0] * d[0] + d[1] * d[1]) + (d[2] * d[2] + d[3] * d[3]); }
        q += __shfl_xor(q, 16); q += __shfl_xor(q, 32);
        const float rstd = rsqrtf(q * (1.0f / 64.0f) + 64e-5f);
#pragma unroll
        for (int mv = 0; mv < 4; ++mv) {
            const int vch = 16 * mv + 4 * fq;
            const f32x4 vmx = ld_bf4(PVt + trow * LD + vch), gb = ld_bf4(GBt + trow * LD + vch);
            f32x4 o = (acc[mv] - mean) * rstd * gng[mv] + gnb[mv] + rk * vmx;
#pragma unroll
            for (int e = 0; e < 4; ++e) o[e] *= silu_f(gb[e]);
            st_bf4(YVt + trow * LD + vch, o);
        }
        LDS_BARRIER();
#pragma unroll
        for (int i = 0; i < 2; ++i) { const int r = crow + 32 * i; *(u32x4*)(p.ACT + (size_t)(row0 + r) * DM + 1024 + h * 64 + cseg) = *(const u32x4*)(YVt + r * LD + cseg); }
        LDS_BARRIER();
    }
}

__device__ __forceinline__ void sgu_item(const Params& p, unsigned char* shm, int tile, int hbase) {
    constexpr int LDT = 136;
    float* stats = (float*)shm;
    bf16_t* vnT = (bf16_t*)(shm + 1024);
    bf16_t* Wm = vnT + 128 * LDT;
    const int tid = threadIdx.x, lane = tid & 63, wid = tid >> 6, fr = lane & 15, fq = lane >> 4;
    const int row0 = tile * 128; const bool samp = row0 >= MP; const int L = samp ? 64 : 128, Lsh = samp ? 6 : 7;
    for (int q0 = 0; q0 < 16; q0 += 4) {
        u32x4 a[4], b[4];
#pragma unroll
        for (int qq = 0; qq < 4; ++qq) { const bf16_t* zr = p.Z + (size_t)(row0 + wid * 16 + q0 + qq) * LDZ + ZC_V + lane * 16; a[qq] = *(const u32x4*)zr; b[qq] = *(const u32x4*)(zr + 8); }
#pragma unroll
        for (int qq = 0; qq < 4; ++qq) {
            const int j = wid * 16 + q0 + qq;
            const unsigned uu[8] = {a[qq].x, a[qq].y, a[qq].z, a[qq].w, b[qq].x, b[qq].y, b[qq].z, b[qq].w};
            float s = 0.f, s2 = 0.f;
#pragma unroll
            for (int i = 0; i < 8; ++i) { const f32x2 g = gelu2(bf2(uu[i])); s += g.x + g.y; s2 += g.x * g.x + g.y * g.y; }

            s = wave_sum(s); s2 = wave_sum(s2);
            const float mean = s * (1.0f / 1024.0f), var = fmaxf(s2 * (1.0f / 1024.0f) - mean * mean, 0.f);
            if (lane == 0) { stats[2 * j] = mean; stats[2 * j + 1] = rsqrtf(var + 1e-5f); }
        }
    }
    LDS_BARRIER();
    for (int h = hbase; h < hbase + 4; ++h) {
        {
            const int jr = tid >> 4, d0 = (tid & 15) * 8, cg = h * 128 + d0;
            const f32x4 lg0 = *(const f32x4*)(p.ln_g + cg), lg1 = *(const f32x4*)(p.ln_g + cg + 4), lb0 = *(const f32x4*)(p.ln_b + cg), lb1 = *(const f32x4*)(p.ln_b + cg + 4);
            u32x4 zv[4];
#pragma unroll
            for (int ps = 0; ps < 4; ++ps) zv[ps] = *(const u32x4*)(p.Z + (size_t)(row0 + ps * 32 + jr) * LDZ + ZC_V + cg);
#pragma unroll
            for (int ps = 0; ps < 4; ++ps) {
                const int j = ps * 32 + jr; const float mean = stats[2 * j], rstd = stats[2 * j + 1];
                const unsigned uw[4] = {zv[ps].x, zv[ps].y, zv[ps].z, zv[ps].w};
                float vn[8];
#pragma unroll
                for (int e = 0; e < 4; ++e) {
                    const f32x2 g = gelu2(bf2(uw[e]));
                    vn[2 * e] = (g.x - mean) * rstd * (e < 2 ? lg0[2 * e] : lg1[2 * e - 4]) + (e < 2 ? lb0[2 * e] : lb1[2 * e - 4]);
                    vn[2 * e + 1] = (g.y - mean) * rstd * (e < 2 ? lg0[2 * e + 1] : lg1[2 * e - 3]) + (e < 2 ? lb0[2 * e + 1] : lb1[2 * e - 3]);
                }
#pragma unroll
                for (int e = 0; e < 8; ++e) vnT[(d0 + e) * LDT + (j ^ (((tid & 15) & 3) << 3))] = f2bf(vn[e]);
                if (samp) { float* o = p.out + O_SGUV + (size_t)(row0 + j - MP) * 1024 + cg; *(f32x4*)o = (f32x4){vn[0], vn[1], vn[2], vn[3]}; *(f32x4*)(o + 4) = (f32x4){vn[4], vn[5], vn[6], vn[7]}; }
            }
        }
        {
            const int ir = tid >> 5, j4 = (tid & 31) * 4, jl = j4 & (L - 1);
            f32x4 w[8];
#pragma unroll
            for (int ps = 0; ps < 8; ++ps) { const int i = ps * 16 + ir; w[ps] = *(const f32x4*)(p.sgu_w + ((size_t)h * 128 + (i & (L - 1))) * 128 + jl); }
#pragma unroll
            for (int ps = 0; ps < 8; ++ps) {
                const int i = ps * 16 + ir, il = i & (L - 1); const bool same = (i >> Lsh) == (j4 >> Lsh);
#pragma unroll
                for (int e = 0; e < 4; ++e) w[ps][e] = (same && jl + e <= il) ? w[ps][e] : 0.f;
                st_bf4(Wm + i * LDT + j4, w[ps]);
            }
        }
        LDS_BARRIER();
        const int ib = wid >> 1, db = wid & 1;
        f32x4 acc[2][4];
#pragma unroll
        for (int mi = 0; mi < 2; ++mi)
#pragma unroll
            for (int nd = 0; nd < 4; ++nd) acc[mi][nd] = (f32x4){0.f, 0.f, 0.f, 0.f};
        for (int ks = 0; ks <= ib; ++ks) {
            bf16x8 bfr[2], afr[4];
#pragma unroll
            for (int mi = 0; mi < 2; ++mi) bfr[mi] = *(const bf16x8*)(Wm + (32 * ib + 16 * mi + fr) * LDT + ks * 32 + fq * 8);
#pragma unroll
            for (int nd = 0; nd < 4; ++nd) afr[nd] = *(const bf16x8*)(vnT + (64 * db + 16 * nd + fr) * LDT + ((ks * 32 + fq * 8) ^ ((((16 * nd + fr) >> 3) & 3) << 3)));
#pragma unroll
            for (int mi = 0; mi < 2; ++mi)
#pragma unroll
                for (int nd = 0; nd < 4; ++nd) acc[mi][nd] = __builtin_amdgcn_mfma_f32_16x16x32_bf16(afr[nd], bfr[mi], acc[mi][nd], 0, 0, 0);
        }
        LDS_BARRIER();
#pragma unroll
        for (int mi = 0; mi < 2; ++mi)
#pragma unroll
            for (int nd = 0; nd < 4; ++nd) st_bf4(Wm + (32 * ib + 16 * mi + fr) * LDT + 64 * db + 16 * nd + 4 * fq, acc[mi][nd]);
        LDS_BARRIER();
        {
            const int jr = tid >> 4, d0 = (tid & 15) * 8, cg = h * 128 + d0;
            u32x4 uu[4], gg[4];
            float biasv[4];
#pragma unroll
            for (int ps = 0; ps < 4; ++ps) { const bf16_t* zr = p.Z + (size_t)(row0 + ps * 32 + jr) * LDZ + cg; uu[ps] = *(const u32x4*)zr; gg[ps] = *(const u32x4*)(zr + ZC_GA); biasv[ps] = p.sgu_b[h * 128 + ((ps * 32 + jr) & (L - 1))]; }
#pragma unroll
            for (int ps = 0; ps < 4; ++ps) {
                const int i = ps * 32 + jr; const float bias = biasv[ps];
                const u32x4 ff = *(const u32x4*)(Wm + i * LDT + d0);
                const unsigned uw[4] = {uu[ps].x, uu[ps].y, uu[ps].z, uu[ps].w}, gw[4] = {gg[ps].x, gg[ps].y, gg[ps].z, gg[ps].w}, fw[4] = {ff.x, ff.y, ff.z, ff.w};
                unsigned ow[4];
#pragma unroll
                for (int e = 0; e < 4; ++e) { const f32x2 o = gelu2(bf2(uw[e])) * (bf2(fw[e]) + bias) * silu2(bf2(gw[e])); ow[e] = pk_bf16(o.x, o.y); }
                *(u32x4*)(p.ACT + (size_t)(row0 + i) * DM + cg) = (u32x4){ow[0], ow[1], ow[2], ow[3]};
            }
        }
        LDS_BARRIER();
    }
}

__device__ __forceinline__ void phase_mix(const Params& p, unsigned char* shm) {
    constexpr int NSCAN_P = 64, NSCAN_S = 512, NSGU = 2 * (MT / 128);
    const int b = blockIdx.x, G = gridDim.x;
    if (G >= 128) {
        if (b < NSCAN_P) { const int sb = b >> 4, h = b & 15; seq_item(p, shm, sb * SEQ, SEQ / 64, h, nullptr, p.out + O_WKVP + (size_t)(sb * 16 + h) * 4096); return; }
        const int nb = G - NSCAN_P, c = b - NSCAN_P;
        for (int it = c; it < NSCAN_S + NSGU; it += nb) {
            if (it < NSCAN_S) { const int sb = it >> 4, h = it & 15; seq_item(p, shm, MP + sb * DSEQ, 1, h, p.st_wkv + (size_t)(sb * 16 + h) * 4096, p.out + O_WKVS + (size_t)(sb * 16 + h) * 4096); }
            else sgu_item(p, shm, (it - NSCAN_S) >> 1, ((it - NSCAN_S) & 1) * 4);
            __syncthreads();
        }
    } else {
        for (int it = b; it < NSCAN_P + NSCAN_S + NSGU; it += G) {
            if (it < NSCAN_P) { const int sb = it >> 4, h = it & 15; seq_item(p, shm, sb * SEQ, SEQ / 64, h, nullptr, p.out + O_WKVP + (size_t)(sb * 16 + h) * 4096); }
            else if (it < NSCAN_P + NSCAN_S) { const int i2 = it - NSCAN_P, sb = i2 >> 4, h = i2 & 15; seq_item(p, shm, MP + sb * DSEQ, 1, h, p.st_wkv + (size_t)(sb * 16 + h) * 4096, p.out + O_WKVS + (size_t)(sb * 16 + h) * 4096); }
            else sgu_item(p, shm, (it - NSCAN_P - NSCAN_S) >> 1, ((it - NSCAN_P - NSCAN_S) & 1) * 4);
            __syncthreads();
        }
    }
}

__device__ __forceinline__ void phase_final(const Params& p) {
    const int tid = threadIdx.x, lane = tid & 63, wid = tid >> 6;
    for (int row = blockIdx.x * 8 + wid; row < MT; row += gridDim.x * 8) {
        const bf16_t* yr = p.QG + (size_t)row * DM; float* xr = p.out + (size_t)row * DM; const float* xi = xrow(p, row);
        u32x4 v[4]; f32x4 y0[4], y1[4]; float ss = 0.f;
#pragma unroll
        for (int i = 0; i < 4; ++i) { const int c = i * 512 + lane * 8; v[i] = *(const u32x4*)(yr + c); y0[i] = *(const f32x4*)(xi + c); y1[i] = *(const f32x4*)(xi + c + 4); }
#pragma unroll
        for (int i = 0; i < 4; ++i) {
            y0[i] += (f32x4){bf_lo(v[i].x), bf_hi(v[i].x), bf_lo(v[i].y), bf_hi(v[i].y)}; y1[i] += (f32x4){bf_lo(v[i].z), bf_hi(v[i].z), bf_lo(v[i].w), bf_hi(v[i].w)};
            ss += y0[i][0] * y0[i][0] + y0[i][1] * y0[i][1] + y0[i][2] * y0[i][2] + y0[i][3] * y0[i][3] + y1[i][0] * y1[i][0] + y1[i][1] * y1[i][1] + y1[i][2] * y1[i][2] + y1[i][3] * y1[i][3]; }
        ss = wave_sum(ss);
        const float rs = rsqrtf(ss * (1.0f / DM) + 1e-6f);
#pragma unroll
        for (int i = 0; i < 4; ++i) { const int c = i * 512 + lane * 8;
            *(f32x4*)(xr + c) = y0[i] * rs * *(const f32x4*)(p.final_g + c); *(f32x4*)(xr + c + 4) = y1[i] * rs * *(const f32x4*)(p.final_g + c + 4); }
    }
}

__device__ __forceinline__ void phase_gemm1(const Params& p, unsigned char* shm) {
    pg8::Gemm g{p.XB, p.WTI, MT, LDZ, DM}; pg8::StaticOrder S; S.init(MT, LDZ, (int)gridDim.x, (int)blockIdx.x);
    EpiZ E{p.Z, p.out};
    pg8::gemm_phase<EpiZ>((LAS unsigned char*)shm, g, S, E);
}
__device__ __forceinline__ void phase_gemm2(const Params& p, unsigned char* shm) {
    pg8::Gemm g{p.ACT, p.WTO, MT, DM, DM}; pg8::StaticOrder S; S.init(MT, DM, (int)gridDim.x, (int)blockIdx.x);
    EpiY E{p.x_prompt, p.x_sample, p.QG};
    pg8::gemm_phase<EpiY>((LAS unsigned char*)shm, g, S, E);
}


#define XB_TMO      128
#define XB_XCNT(j)  (256  + 64 * (j))
#define XB_XSUB(j)  (1280 + 64 * (j))
#define XB_XGEN(j)  (2304 + 64 * (j))
#define XB_TOP      3328
#define XB_TOPGEN   3392
#define XCD_BAR_WORDS 3456
#define XB_SPIN_CAP (1u << 18)
__device__ __forceinline__ unsigned xb_ld(unsigned* p)              { return __hip_atomic_load(p, __ATOMIC_RELAXED, __HIP_MEMORY_SCOPE_AGENT); }
__device__ __forceinline__ unsigned xb_add(unsigned* p, unsigned v) { return __hip_atomic_fetch_add(p, v, __ATOMIC_RELAXED, __HIP_MEMORY_SCOPE_AGENT); }
__device__ __forceinline__ unsigned xb_xcc_id() { return (unsigned)__builtin_amdgcn_s_getreg((3 << 11) | 20) & 0xFu; }
#define XB_SPIN(cond, bar) do { unsigned _sp = 0; while (cond) { __builtin_amdgcn_s_sleep(1); \
    if ((++_sp & 255u) == 0u) { if (xb_ld(&(bar)[XB_TMO])) break; if (_sp > XB_SPIN_CAP) { atomicAdd(&(bar)[XB_TMO], 1u); break; } } } } while (0)
struct XcdBarrier { unsigned* bar; unsigned x, nloc, nx; };
__device__ __forceinline__ XcdBarrier xcd_barrier_post(unsigned* bar) {
    XcdBarrier b; b.bar = bar; b.x = xb_xcc_id(); b.nloc = 0u; b.nx = 0u;
    if (threadIdx.x == 0) (void)xb_add(&bar[XB_XCNT(b.x)], 1u);
    return b;
}
__device__ __forceinline__ void xcd_barrier_complete(unsigned* bar, unsigned x, unsigned& nloc, unsigned& nx) {
    const unsigned G = gridDim.x * gridDim.y * gridDim.z;
    unsigned sum, cnt, mine, sp = 0u;
    for (;;) {
        sum = 0u; cnt = 0u; mine = 0u;
#pragma unroll
        for (unsigned j = 0; j < 16; ++j) { const unsigned c = xb_ld(&bar[XB_XCNT(j)]); sum += c; cnt += (c > 0u) ? 1u : 0u; mine = (j == x) ? c : mine; }
        if (sum == G) break;
        __builtin_amdgcn_s_sleep(1);
        if ((++sp & 255u) == 0u) { if (xb_ld(&bar[XB_TMO])) break; if (sp > XB_SPIN_CAP) { atomicAdd(&bar[XB_TMO], 1u); break; } }
    }
    nloc = mine > 0u ? mine : 1u; nx = cnt > 0u ? cnt : 1u;
}
__device__ __forceinline__ void xcd_barrier(XcdBarrier& b) {
    asm volatile("s_waitcnt vmcnt(0)" ::: "memory");
    __syncthreads();
    if (threadIdx.x == 0) {
        unsigned* bar = b.bar;
        __builtin_amdgcn_s_waitcnt(0);
        if (b.nloc == 0u) xcd_barrier_complete(bar, b.x, b.nloc, b.nx);
        const unsigned nloc = b.nloc, nx = b.nx;
        const unsigned old = xb_add(&bar[XB_XSUB(b.x)], 1u);
        const unsigned gen = old / nloc;
        if (old + 1u == (gen + 1u) * nloc) {
            __builtin_amdgcn_fence(__ATOMIC_RELEASE, "agent");
            asm volatile("s_waitcnt vmcnt(0)" ::: "memory");
            const unsigned og = xb_add(&bar[XB_TOP], 1u);
            const unsigned tg = og / nx;
            if (og + 1u == (tg + 1u) * nx) xb_add(&bar[XB_TOPGEN], 1u);
            else XB_SPIN(xb_ld(&bar[XB_TOPGEN]) == tg, bar);
            __builtin_amdgcn_fence(__ATOMIC_ACQUIRE, "agent");
            xb_add(&bar[XB_XGEN(b.x)], 1u);
            asm volatile("s_waitcnt vmcnt(0)" ::: "memory");
        } else {
            XB_SPIN(xb_ld(&bar[XB_XGEN(b.x)]) == gen, bar);
            __builtin_amdgcn_fence(__ATOMIC_ACQUIRE, "agent");
            asm volatile("s_waitcnt vmcnt(0)" ::: "memory");
        }
    }
    __syncthreads();
}

typedef const __attribute__((address_space(4))) Params* CParams;
__device__ __forceinline__ CParams cp_launder(CParams c) { asm volatile("" : "+s"(c)); return c; }
__global__ __launch_bounds__(512, 2) void k_mega(Params p) {
    extern __shared__ __attribute__((aligned(16))) unsigned char shm[];
    cg::grid_group grid = cg::this_grid();
    CParams cp = (CParams)__builtin_amdgcn_kernarg_segment_ptr();
    XcdBarrier xb = xcd_barrier_post(cp->BAR);
#define P() (*(const Params*)(cp = cp_launder(cp)))
    phase_convert(P(), shm); xcd_barrier(xb);
    if (cp->BAR == nullptr) grid.sync();
    phase_gemm1(P(), shm); xcd_barrier(xb);
    phase_prep(P(), shm); xcd_barrier(xb);
    phase_mix(P(), shm); xcd_barrier(xb);
    phase_out(P(), shm); xcd_barrier(xb);
    phase_gemm2(P(), shm); xcd_barrier(xb);
    phase_final(P());
#undef P
}
template <int PH> __global__ __launch_bounds__(512, 2) void k_one(Params p) {
    extern __shared__ __attribute__((aligned(16))) unsigned char shm[];
    if (PH == 0) phase_convert(p, shm);
    if (PH == 1) phase_gemm1(p, shm);
    if (PH == 2) phase_prep(p, shm);
    if (PH == 3) phase_mix(p, shm);
    if (PH == 4) phase_gemm2(p, shm);
    if (PH == 5) phase_final(p);
    if (PH == 6) phase_out(p, shm);
}

extern "C" void kernel_launch(void* const* d_in, const int* in_sizes, int n_in, void* d_out, int out_size, void* d_ws, size_t ws_size, hipStream_t stream) {
    Params p{};
    const float* const* in = (const float* const*)d_in;
    p.x_prompt = in[0]; p.x_sample = in[1]; p.st_wkv = in[2]; p.st_shift = in[3]; p.norm_g = in[4]; p.w_in = in[5]; p.w_out = in[6]; p.ln_g = in[7]; p.ln_b = in[8];
    p.sgu_w = in[9]; p.sgu_b = in[10]; p.mu = in[11]; p.w0 = in[12]; p.w2 = in[13]; p.a0 = in[14]; p.a2 = in[15]; p.k_k = in[16]; p.k_a = in[17]; p.r_k = in[18];
    p.gn_g = in[19]; p.gn_b = in[20]; p.final_g = in[21];
    p.out = (float*)d_out;
    char* ws = (char*)d_ws; size_t off = 0;
    auto take = [&](size_t bytes) { char* r = ws + off; off += (bytes + 255) & ~(size_t)255; return r; };
    p.Z = (bf16_t*)take((size_t)MT * LDZ * 2);
    p.XB = (bf16_t*)take((size_t)MT * DM * 2); p.ACT = p.XB;
    p.WTI = (bf16_t*)take((size_t)LDZ * DM * 2);
    p.WTO = (bf16_t*)take((size_t)DM * DM * 2);
    const size_t CHB = (size_t)MT * 1024 * 2;
    p.QG = (bf16_t*)take(CHB); p.AQBG = (bf16_t*)take(CHB); p.YVG = (bf16_t*)take(CHB); p.PV = (bf16_t*)take(CHB); p.UTG = (bf16_t*)take(CHB);
    p.PRK = (float*)take((size_t)MT * 16 * 4);
    p.GCG = (float*)take((size_t)NCH * 16 * 64 * 4);
    p.BAR = (unsigned*)take((size_t)XCD_BAR_WORDS * 4);
    if (off > ws_size) { fprintf(stderr, "workspace too small: need %zu have %zu\n", off, ws_size); return; }
    bf16_t* oscr = (bf16_t*)d_out;
    p.W1G = oscr; p.BPG = oscr + (size_t)MT * 1024; p.U0G = oscr + (size_t)2 * MT * 1024; p.VKG = oscr + (size_t)3 * MT * 1024;
#if MEGA
    static int grid_blocks = 0;
    if (!grid_blocks) {
        hipFuncSetAttribute((const void*)k_mega, hipFuncAttributeMaxDynamicSharedMemorySize, LDS_BYTES);
        int dev = 0, cus = 0, per_cu = 0;
        hipGetDevice(&dev);
        hipDeviceGetAttribute(&cus, hipDeviceAttributeMultiprocessorCount, dev);
        hipOccupancyMaxActiveBlocksPerMultiprocessor(&per_cu, k_mega, 512, LDS_BYTES);
        if (per_cu < 1) per_cu = 1;
        grid_blocks = (cus / 16) * 16;
    }
    (void)hipMemsetAsync(p.BAR, 0, (size_t)XCD_BAR_WORDS * 4, stream);
    void* args[] = {&p};
    hipError_t e = hipLaunchCooperativeKernel((const void*)k_mega, dim3(grid_blocks), dim3(512), args, LDS_BYTES, stream);
    if (e != hipSuccess) fprintf(stderr, "cooperative launch failed: %s (grid %d)\n", hipGetErrorString(e), grid_blocks);
#else
    const int G = 256;
    hipFuncSetAttribute((const void*)k_one<0>, hipFuncAttributeMaxDynamicSharedMemorySize, LDS_BYTES);
    hipFuncSetAttribute((const void*)k_one<1>, hipFuncAttributeMaxDynamicSharedMemorySize, LDS_BYTES);
    hipFuncSetAttribute((const void*)k_one<2>, hipFuncAttributeMaxDynamicSharedMemorySize, LDS_BYTES);
    hipFuncSetAttribute((const void*)k_one<3>, hipFuncAttributeMaxDynamicSharedMemorySize, LDS_BYTES);
    hipFuncSetAttribute((const void*)k_one<4>, hipFuncAttributeMaxDynamicSharedMemorySize, LDS_BYTES);
    hipFuncSetAttribute((const void*)k_one<5>, hipFuncAttributeMaxDynamicSharedMemorySize, LDS_BYTES);
    hipFuncSetAttribute((const void*)k_one<6>, hipFuncAttributeMaxDynamicSharedMemorySize, LDS_BYTES);
    k_one<0><<<G, 512, LDS_BYTES, stream>>>(p);
    k_one<1><<<G, 512, LDS_BYTES, stream>>>(p);
    k_one<2><<<G, 512, LDS_BYTES, stream>>>(p);
    k_one<3><<<G, 512, LDS_BYTES, stream>>>(p);
    k_one<6><<<G, 512, LDS_BYTES, stream>>>(p);
    k_one<4><<<G, 512, LDS_BYTES, stream>>>(p);
    k_one<5><<<G, 512, LDS_BYTES, stream>>>(p);
#endif
}
```

```cpp
#include <hip/hip_runtime.h>
#include <hip/hip_cooperative_groups.h>
#include <cstdio>
namespace cg = cooperative_groups;

#ifndef MEGA
#define MEGA 1
#endif

#define LAS __attribute__((address_space(3)))
typedef unsigned short bf16_t;
typedef short bf16x8 __attribute__((ext_vector_type(8)));
typedef float f32x4 __attribute__((ext_vector_type(4)));
typedef float f32x2 __attribute__((ext_vector_type(2)));
typedef unsigned u32x4 __attribute__((ext_vector_type(4)));
typedef unsigned u32x2 __attribute__((ext_vector_type(2)));

constexpr int DM = 2048, MP = 32768, MS = 2048, MT = MP + MS;
constexpr int SEQ = 8192, DSEQ = 64, NSHIFT = 3200, DPROJ = 7296, LDZ = 7424;
constexpr int ZC_V = 1024, ZC_GA = 2048, ZC_S = 3072, ZC_GB = 6272;
constexpr size_t O_YP = 0, O_WKVP = 71303168, O_SHP = 71565312, O_WKVS = 71578112, O_SHS = 73675264, O_SGUV = 73777664;
constexpr int LDS_BYTES = 163840;

struct Params {
    const float *x_prompt, *x_sample, *st_wkv, *st_shift, *norm_g, *w_in, *w_out, *ln_g, *ln_b, *sgu_w, *sgu_b, *mu, *w0, *w2, *a0, *a2, *k_k, *k_a, *r_k, *gn_g, *gn_b, *final_g;
    float* out;
    bf16_t *Z, *XB, *ACT, *WTI, *WTO, *PV, *QG, *AQBG, *YVG, *UTG, *W1G, *BPG, *U0G, *VKG;
    float *PRK, *GCG; unsigned* BAR;
};

typedef __bf16 bf16v2 __attribute__((ext_vector_type(2)));
__device__ __forceinline__ unsigned pk_bf16(float lo, float hi) { const f32x2 v = (f32x2){lo, hi}; const bf16v2 b = __builtin_convertvector(v, bf16v2); return __builtin_bit_cast(unsigned, b); }
__device__ __forceinline__ float bf_lo(unsigned u) { return __uint_as_float(u << 16); }
__device__ __forceinline__ float bf_hi(unsigned u) { return __uint_as_float(u & 0xffff0000u); }
__device__ __forceinline__ float bf2f(bf16_t b) { return __uint_as_float(((unsigned)b) << 16); }
__device__ __forceinline__ bf16_t f2bf(float f) { return (bf16_t)(pk_bf16(f, 0.f) & 0xffffu); }
__device__ __forceinline__ float wave_sum(float v) {
#pragma unroll
    for (int o = 32; o > 0; o >>= 1) v += __shfl_xor(v, o);
    return v;
}
__device__ __forceinline__ float sigmoid_f(float x) { return __builtin_amdgcn_rcpf(1.0f + __builtin_amdgcn_exp2f(-1.44269504089f * x)); }
__device__ __forceinline__ float tanh_f(float x) { return 1.0f - 2.0f * __builtin_amdgcn_rcpf(1.0f + __builtin_amdgcn_exp2f(2.88539008178f * x)); }
__device__ __forceinline__ float silu_f(float x) { return x * __builtin_amdgcn_rcpf(1.0f + __builtin_amdgcn_exp2f(-1.44269504089f * x)); }
__device__ __forceinline__ float gelu_f(float v) {
    const float av = fabsf(v), t = __builtin_amdgcn_rcpf(av * 0.2316418882f + 1.0f);
    float q = t * 0.5307027145f + (-0.7265760135f); q = q * t + 0.7107068705f; q = q * t + (-0.142248368f); q = q * t + 0.127414796f; q = q * t;
    const float e = __builtin_amdgcn_exp2f((v * v) * (-0.72134752044f));
    const float m = v * (q * e);
    return v < 0.f ? m : v - m;
}
__device__ __forceinline__ f32x2 gelu2(f32x2 v) {
    const f32x2 av = __builtin_elementwise_abs(v), d = av * 0.2316418882f + 1.0f;
    f32x2 t; t.x = __builtin_amdgcn_rcpf(d.x); t.y = __builtin_amdgcn_rcpf(d.y);
    f32x2 q = t * 0.5307027145f + (-0.7265760135f); q = q * t + 0.7107068705f; q = q * t + (-0.142248368f); q = q * t + 0.127414796f; q = q * t;
    const f32x2 s = (v * v) * (-0.72134752044f);
    f32x2 e; e.x = __builtin_amdgcn_exp2f(s.x); e.y = __builtin_amdgcn_exp2f(s.y);
    const f32x2 m = av * (q * e);
    return __builtin_elementwise_max(v, (f32x2){0.f, 0.f}) - m;
}
__device__ __forceinline__ f32x2 silu2(f32x2 v) {
    const f32x2 s = v * (-1.44269504089f);
    f32x2 e; e.x = __builtin_amdgcn_exp2f(s.x); e.y = __builtin_amdgcn_exp2f(s.y);
    const f32x2 d = e + 1.0f;
    f32x2 r; r.x = __builtin_amdgcn_rcpf(d.x); r.y = __builtin_amdgcn_rcpf(d.y);
    return v * r;
}
__device__ __forceinline__ f32x2 bf2(unsigned u) { return (f32x2){bf_lo(u), bf_hi(u)}; }
__device__ __forceinline__ const float* xrow(const Params& p, int row) { return row < MP ? p.x_prompt + (size_t)row * DM : p.x_sample + (size_t)(row - MP) * DM; }
__device__ __forceinline__ bool seq_first(int row) { return row < MP ? (row & (SEQ - 1)) == 0 : ((row - MP) & (DSEQ - 1)) == 0; }

namespace pg8 {
constexpr int BM = 256, BK = 64, HALF = 128, HTB = HALF * BK * 2, STAGE_BYTES = 8 * HTB, NXCD = 8, WGM = 8;
__host__ __device__ __forceinline__ int lds_byte(int r, int c) { const int st = (r >> 4) * 2 + (c >> 5), rr = r & 15, cc = c & 31, ob = rr * 64 + cc * 2; return st * 1024 + (ob ^ (((ob >> 9) & 1) << 5)); }
__host__ __device__ __forceinline__ void stage_rc(int b, int& R, int& C) { const int st = b / 1024, sb = b % 1024, swz = sb ^ (((sb >> 9) & 1) << 5); R = (st >> 1) * 16 + swz / 64; C = (st & 1) * 32 + (swz % 64) / 2; }
__host__ __device__ __forceinline__ int perm32(int rho) { const int n = rho >> 4, i = rho & 15; return 8 * (i >> 2) + 4 * n + (i & 3); }
struct Unit { int pm, pn; };
struct Gemm { const bf16_t* A; const bf16_t* Bt; int M, N, K; };
struct StaticOrder {
    int nM, nN, nwg, G, c;
    __device__ void init(int M, int N, int G_, int c_) { nM = M / BM; nN = N / BM; nwg = nM * nN; G = G_; c = c_; }
    __device__ bool next(int i, Unit& u) const {
        const long L = (long)i * G + c; if (L >= nwg) return false;
        int wgid = (int)L; { const int q = nwg / NXCD, r = nwg % NXCD, xcd = wgid % NXCD, off = wgid / NXCD; wgid = (xcd < r ? xcd * (q + 1) : r * (q + 1) + (xcd - r) * q) + off; }
        const int nig = WGM * nN, gid = wgid / nig, fm = gid * WGM, gsz = (nM - fm) < WGM ? (nM - fm) : WGM;
        u.pm = fm + ((wgid % nig) % gsz); u.pn = (wgid % nig) / gsz; return true;
    }
};

template <class Epi>
__device__ __forceinline__ void gemm_phase(LAS unsigned char* lds, const Gemm g, const StaticOrder& S, const Epi& E) {
    const int tid = threadIdx.x, wid = __builtin_amdgcn_readfirstlane(tid >> 6), lane = tid & 63, wr = wid >> 2, wc = wid & 3, fr = lane & 15, fq = lane >> 4;
    const int K = g.K, nt = K / BK;
    unsigned voffA[2], voffB[2];
#pragma unroll
    for (int i = 0; i < 2; ++i) { int R, C; stage_rc(tid * 16 + i * 8192, R, C); const int Rb = Epi::PERM ? ((R & ~31) + perm32(R & 31)) : R;
        voffA[i] = (unsigned)(R * K + C) * 2u; voffB[i] = (unsigned)(Rb * K + C) * 2u; }
    const size_t kstep = (size_t)(BK * 2);
    const size_t hstep = (size_t)HALF * K * 2;
    const size_t tstep = 2 * hstep;
    const unsigned ldsw = (unsigned)wid * 1024u;
    const int aoff = lds_byte(wr * 64 + fr, fq * 8), boff = lds_byte(wc * 32 + fr, fq * 8);
#define PG8_SA(b, h) (((b) * 2 + (h)) * HTB)
#define PG8_SB(b, h) ((4 + (b) * 2 + (h)) * HTB)
#define PG8_STAGE(bufoff, gbase, voff) do { _Pragma("unroll") for (int _i = 0; _i < 2; ++_i) \
        __builtin_amdgcn_global_load_lds((const unsigned*)((const char*)(gbase) + (voff)[_i]), (LAS unsigned*)(lds + (bufoff) + ldsw + _i * 8192), 16, 0, 0); } while (0)
#define PG8_LDA(dst, b, h) do { _Pragma("unroll") for (int m = 0; m < 4; ++m) _Pragma("unroll") for (int k = 0; k < 2; ++k) dst[m][k] = *(const LAS bf16x8*)(lds + PG8_SA(b, h) + aoff + m * 2048 + k * 1024); } while (0)
#define PG8_LDB(dst, b, h) do { _Pragma("unroll") for (int n = 0; n < 2; ++n) _Pragma("unroll") for (int k = 0; k < 2; ++k) dst[n][k] = *(const LAS bf16x8*)(lds + PG8_SB(b, h) + boff + n * 2048 + k * 1024); } while (0)
#define PG8_MMA(ai, bj, At, Bt) do { __builtin_amdgcn_s_setprio(1); _Pragma("unroll") for (int m = 0; m < 4; ++m) _Pragma("unroll") for (int n = 0; n < 2; ++n) _Pragma("unroll") for (int k = 0; k < 2; ++k) \
        acc[ai][bj][m][n] = __builtin_amdgcn_mfma_f32_16x16x32_bf16(Bt[n][k], At[m][k], acc[ai][bj][m][n], 0, 0, 0); __builtin_amdgcn_s_setprio(0); } while (0)
#define PG8_WAIT_V(n) asm volatile("s_waitcnt vmcnt(" #n ")" ::: "memory")
#define PG8_WAIT_L(n) asm volatile("s_waitcnt lgkmcnt(" #n ")" ::: "memory")
#define PG8_BAR __builtin_amdgcn_s_barrier()
#define PG8_SCHED __builtin_amdgcn_sched_barrier(0)
    Unit cur, nxt; int ui = 0;
    if (!S.next(0, cur)) return;
    f32x4 acc[2][2][4][2];
#pragma unroll
    for (int a = 0; a < 2; ++a)
#pragma unroll
        for (int b = 0; b < 2; ++b)
#pragma unroll
            for (int m = 0; m < 4; ++m)
#pragma unroll
                for (int n = 0; n < 2; ++n) acc[a][b][m][n] = (f32x4){0.f, 0.f, 0.f, 0.f};
    bf16x8 At[4][2], B0[2][2], B1[2][2];
    const char* cA = (const char*)g.A + (size_t)cur.pm * tstep; const char* cB = (const char*)g.Bt + (size_t)cur.pn * tstep;
    PG8_STAGE(PG8_SB(0, 0), cB, voffB); PG8_STAGE(PG8_SA(0, 0), cA, voffA); PG8_STAGE(PG8_SB(0, 1), cB + hstep, voffB); PG8_STAGE(PG8_SA(0, 1), cA + hstep, voffA);
    if (wr == 1) PG8_BAR;
    PG8_WAIT_V(4); PG8_BAR;
    PG8_STAGE(PG8_SB(1, 0), cB + kstep, voffB); PG8_STAGE(PG8_SA(1, 0), cA + kstep, voffA); PG8_STAGE(PG8_SB(1, 1), cB + hstep + kstep, voffB);
    PG8_WAIT_V(6); PG8_BAR;
    for (;;) {
        const bool has_next = S.next(ui + 1, nxt);
        const char* nA = has_next ? (const char*)g.A + (size_t)nxt.pm * tstep : cA; const char* nB = has_next ? (const char*)g.Bt + (size_t)nxt.pn * tstep : cB;
        for (int t = 0; t < nt; t += 2) {
            const bool last = (t == nt - 2);
            const char* a1 = cA + (size_t)(t + 1) * kstep;
            const char* a2 = last ? nA : cA + (size_t)(t + 2) * kstep; const char* b2 = last ? nB : cB + (size_t)(t + 2) * kstep;
            const char* a3 = a2 + kstep; const char* b3 = b2 + kstep;
            PG8_LDB(B0, 0, 0); PG8_SCHED; PG8_LDA(At, 0, 0); PG8_STAGE(PG8_SA(1, 1), a1 + hstep, voffA);
            PG8_WAIT_L(8); PG8_BAR; PG8_WAIT_L(0); PG8_MMA(0, 0, At, B0); PG8_BAR; PG8_SCHED;
            PG8_LDB(B1, 0, 1); PG8_STAGE(PG8_SB(0, 0), b2, voffB);
            PG8_BAR; PG8_WAIT_L(0); PG8_MMA(0, 1, At, B1); PG8_BAR;
            PG8_LDA(At, 0, 1); PG8_STAGE(PG8_SA(0, 0), a2, voffA);
            PG8_BAR; PG8_WAIT_L(0); PG8_MMA(1, 0, At, B0); PG8_BAR; PG8_SCHED;
            PG8_STAGE(PG8_SB(0, 1), b2 + hstep, voffB);
            PG8_WAIT_V(6); PG8_BAR; PG8_MMA(1, 1, At, B1); PG8_BAR;
            PG8_LDB(B0, 1, 0); PG8_SCHED; PG8_LDA(At, 1, 0); PG8_STAGE(PG8_SA(0, 1), a2 + hstep, voffA);
            PG8_WAIT_L(8); PG8_BAR; PG8_WAIT_L(0); PG8_MMA(0, 0, At, B0); PG8_BAR; PG8_SCHED;
            PG8_LDB(B1, 1, 1); PG8_STAGE(PG8_SB(1, 0), b3, voffB);
            PG8_BAR; PG8_WAIT_L(0); PG8_MMA(0, 1, At, B1); PG8_BAR;
            PG8_LDA(At, 1, 1); PG8_STAGE(PG8_SA(1, 0), a3, voffA);
            PG8_BAR; PG8_WAIT_L(0); PG8_MMA(1, 0, At, B0); PG8_BAR; PG8_SCHED;
            PG8_STAGE(PG8_SB(1, 1), b3 + hstep, voffB);
            PG8_WAIT_V(6); PG8_BAR; PG8_MMA(1, 1, At, B1); PG8_BAR;
        }
        E(acc, cur, wr, wc, fr, fq);
        if (!has_next) break;
#pragma unroll
        for (int a = 0; a < 2; ++a)
#pragma unroll
            for (int b = 0; b < 2; ++b)
#pragma unroll
                for (int m = 0; m < 4; ++m)
#pragma unroll
                    for (int n = 0; n < 2; ++n) acc[a][b][m][n] = (f32x4){0.f, 0.f, 0.f, 0.f};
        cur = nxt; cA = nA; cB = nB; ++ui;
    }
    PG8_WAIT_V(0);
    if (wr == 0) PG8_BAR;
    PG8_BAR;
#undef PG8_SA
#undef PG8_SB
#undef PG8_STAGE
#undef PG8_LDA
#undef PG8_LDB
#undef PG8_MMA
#undef PG8_WAIT_V
#undef PG8_WAIT_L
#undef PG8_BAR
#undef PG8_SCHED
}
}

struct EpiZ {
    static constexpr bool PERM = true;
    bf16_t* Z; float* out;
    __device__ __forceinline__ void operator()(const f32x4 (&acc)[2][2][4][2], const pg8::Unit& u, int wr, int wc, int fr, int fq) const {
        const int row0 = u.pm * 256 + wr * 64 + fr, col0 = u.pn * 256 + wc * 32 + 8 * fq;
#pragma unroll
        for (int ai = 0; ai < 2; ++ai)
#pragma unroll
            for (int m = 0; m < 4; ++m) {
                const int row = row0 + ai * 128 + m * 16;
                bf16_t* rowp = Z + (size_t)row * LDZ + col0;
                const bool last = ((row & 63) == 63) && (row >= MP || (row & (SEQ - 1)) == SEQ - 1);
#pragma unroll
                for (int bj = 0; bj < 2; ++bj) {
                    const f32x4 v0 = acc[ai][bj][m][0], v1 = acc[ai][bj][m][1];
                    u32x4 w; w.x = pk_bf16(v0[0], v0[1]); w.y = pk_bf16(v0[2], v0[3]); w.z = pk_bf16(v1[0], v1[1]); w.w = pk_bf16(v1[2], v1[3]);
                    *(u32x4*)(rowp + bj * 128) = w;
                    if (last) {
                        const int c = col0 + bj * 128 - ZC_S;
                        if (c >= 0 && c < NSHIFT) {
                            float* o = row < MP ? out + O_SHP + (size_t)(row >> 13) * NSHIFT + c : out + O_SHS + (size_t)((row - MP) >> 6) * NSHIFT + c;
                            *(f32x4*)o = v0; *(f32x4*)(o + 4) = v1;
                        }
                    }
                }
            }
    }
};
struct EpiY {
    static constexpr bool PERM = true;
    const float *xp, *xs; bf16_t* yb;
    __device__ __forceinline__ void operator()(const f32x4 (&acc)[2][2][4][2], const pg8::Unit& u, int wr, int wc, int fr, int fq) const {
        const int row0 = u.pm * 256 + wr * 64 + fr, col0 = u.pn * 256 + wc * 32 + 8 * fq;
#pragma unroll
        for (int ai = 0; ai < 2; ++ai)
#pragma unroll
            for (int m = 0; m < 4; ++m) {
                const int row = row0 + ai * 128 + m * 16;
                bf16_t* orow = yb + (size_t)row * DM + col0;
#pragma unroll
                for (int bj = 0; bj < 2; ++bj) {
                    const f32x4 v0 = acc[ai][bj][m][0], v1 = acc[ai][bj][m][1];
                    *(u32x4*)(orow + bj * 128) = (u32x4){pk_bf16(v0[0], v0[1]), pk_bf16(v0[2], v0[3]), pk_bf16(v1[0], v1[1]), pk_bf16(v1[2], v1[3])};
                }
            }
    }
};

__device__ __forceinline__ void phase_convert(const Params& p, unsigned char* shm) {
    const int tid = threadIdx.x, lane = tid & 63, wid = tid >> 6;
    for (int row = blockIdx.x * 8 + wid; row < MT; row += gridDim.x * 8) {
        const float* xr = xrow(p, row);
        f32x4 v[8]; float ss = 0.f;
#pragma unroll
        for (int i = 0; i < 8; ++i) { v[i] = *(const f32x4*)(xr + i * 256 + lane * 4); ss += v[i][0] * v[i][0] + v[i][1] * v[i][1] + v[i][2] * v[i][2] + v[i][3] * v[i][3]; }
        ss = wave_sum(ss);
        const float rs = rsqrtf(ss * (1.0f / DM) + 1e-6f);
        bf16_t* o = p.XB + (size_t)row * DM;
#pragma unroll
        for (int i = 0; i < 8; ++i) { u32x2 w; w.x = pk_bf16(v[i][0] * rs, v[i][1] * rs); w.y = pk_bf16(v[i][2] * rs, v[i][3] * rs); *(u32x2*)(o + i * 256 + lane * 4) = w; }
    }
    float* tw = (float*)shm + wid * (64 * 65);
    constexpr int NT_IN = 32 * (LDZ / 64), NT_OUT = 32 * 32;
    for (int tile = blockIdx.x * 8 + wid; tile < NT_IN + NT_OUT; tile += gridDim.x * 8) {
        const bool is_in = tile < NT_IN; const int tl = is_in ? tile : tile - NT_IN;
        const int kt = tl & 31, ntile = tl >> 5, k0 = kt * 64, n0 = ntile * 64;
        const int N = is_in ? DPROJ : DM; const float* w = is_in ? p.w_in : p.w_out; bf16_t* wt = is_in ? p.WTI : p.WTO;
        const bool valid = n0 < N;
        const int rr = lane >> 4, c4 = (lane & 15) * 4;
        f32x4 v[16]; float gsc[16];
#pragma unroll
        for (int i = 0; i < 16; ++i) { const int r = 4 * i + rr; const size_t o = valid ? (size_t)(k0 + r) * N + n0 + c4 : 0; v[i] = *(const f32x4*)(w + o); gsc[i] = p.norm_g[k0 + r]; }
#pragma unroll
        for (int i = 0; i < 16; ++i) { const int r = 4 * i + rr; const float sc = valid ? (is_in ? gsc[i] : 1.0f) : 0.0f; const f32x4 x = v[i] * sc;
            tw[r * 65 + c4] = x[0]; tw[r * 65 + c4 + 1] = x[1]; tw[r * 65 + c4 + 2] = x[2]; tw[r * 65 + c4 + 3] = x[3]; }
        asm volatile("s_waitcnt lgkmcnt(0)" ::: "memory"); __builtin_amdgcn_wave_barrier();
        const int k8 = (lane & 7) * 8;
#pragma unroll
        for (int ps = 0; ps < 8; ++ps) { const int n = ps * 8 + (lane >> 3); float f[8];
#pragma unroll
            for (int j = 0; j < 8; ++j) f[j] = tw[(k8 + j) * 65 + n];
            u32x4 o; o.x = pk_bf16(f[0], f[1]); o.y = pk_bf16(f[2], f[3]); o.z = pk_bf16(f[4], f[5]); o.w = pk_bf16(f[6], f[7]);
            *(u32x4*)(wt + (size_t)(n0 + n) * DM + k0 + k8) = o; }
        asm volatile("s_waitcnt lgkmcnt(0)" ::: "memory"); __builtin_amdgcn_wave_barrier();
    }
}

__device__ __forceinline__ f32x4 ld_bf4(const bf16_t* p) { const u32x2 u = *(const u32x2*)p; return (f32x4){bf_lo(u.x), bf_hi(u.x), bf_lo(u.y), bf_hi(u.y)}; }
__device__ __forceinline__ void st_bf4(bf16_t* p, f32x4 v) { u32x2 u; u.x = pk_bf16(v[0], v[1]); u.y = pk_bf16(v[2], v[3]); *(u32x2*)p = u; }
__device__ __forceinline__ f32x4 zs_prev4(const Params& p, int row, int c) {
    const int prow = row > 0 ? row - 1 : 0, sb = row >= MP ? (row - MP) >> 6 : 0;
    const f32x4 zp = ld_bf4(p.Z + (size_t)prow * LDZ + ZC_S + c), sp = *(const f32x4*)(p.st_shift + (size_t)sb * NSHIFT + c);
    const bool first = seq_first(row), samp = row >= MP;
    f32x4 r;
#pragma unroll
    for (int e = 0; e < 4; ++e) r[e] = first ? (samp ? sp[e] : 0.f) : zp[e];
    return r;
}
#define LDS_BARRIER() do { asm volatile("s_waitcnt lgkmcnt(0)" ::: "memory"); __builtin_amdgcn_s_barrier(); asm volatile("" ::: "memory"); } while (0)
#define MFMA16(a, b, c) __builtin_amdgcn_mfma_f32_16x16x32_bf16(a, b, c, 0, 0, 0)
__device__ __forceinline__ bf16x8 ldfrag(const bf16_t* X, int ld, int row0, int k0, int fr, int fq) { return *(const bf16x8*)(X + (size_t)(row0 + fr) * ld + k0 + 8 * fq); }
__device__ __forceinline__ f32x4 up_bf4(u32x2 u) { return (f32x4){bf_lo(u.x), bf_hi(u.x), bf_lo(u.y), bf_hi(u.y)}; }
__device__ __forceinline__ u32x2 pk_bf4(f32x4 v) { u32x2 u; u.x = pk_bf16(v[0], v[1]); u.y = pk_bf16(v[2], v[3]); return u; }
constexpr int NCH = MT / 64;

__device__ __forceinline__ bf16x8 cvt_frag8(const float* s) {
    const f32x4 a = *(const f32x4*)s, b = *(const f32x4*)(s + 4);
    const u32x4 u = (u32x4){pk_bf16(a[0], a[1]), pk_bf16(a[2], a[3]), pk_bf16(b[0], b[1]), pk_bf16(b[2], b[3])};
    return __builtin_bit_cast(bf16x8, u);
}
#define WAVE_SYNC() do { asm volatile("s_waitcnt lgkmcnt(0)" ::: "memory"); __builtin_amdgcn_wave_barrier(); } while (0)
__device__ __forceinline__ void tinv_wave(const float* Aab, bf16_t* Tm, bf16_t* TT, bf16_t* ET, bf16_t* E2T, int lane) {
    constexpr int LD = 72;
    const int fr = lane & 15, fq = lane >> 4;
    const bf16x8 zf = (bf16x8){0, 0, 0, 0, 0, 0, 0, 0};
    {
        const u32x4 z = (u32x4){0u, 0u, 0u, 0u};
#pragma unroll
        for (int i = 0; i < 9; ++i) { *(u32x4*)(Tm + lane * LD + i * 8) = z; *(u32x4*)(TT + lane * LD + i * 8) = z; }
    }
    WAVE_SYNC();
    {
        const int q = fq, c = fr; const float* Ab = Aab + (16 * q) * 68 + 16 * q;
        float d[16];
#pragma unroll
        for (int i = 0; i < 16; ++i) {
            float a = (i == c) ? 1.0f : 0.0f;
#pragma unroll
            for (int m = 0; m < i; ++m) a -= Ab[i * 68 + m] * d[m];
            d[i] = a;
            if ((i & 3) == 3) __builtin_amdgcn_sched_barrier(0);
        }
        u32x4 lo, hi;
        lo.x = pk_bf16(d[0], d[1]); lo.y = pk_bf16(d[2], d[3]); lo.z = pk_bf16(d[4], d[5]); lo.w = pk_bf16(d[6], d[7]);
        hi.x = pk_bf16(d[8], d[9]); hi.y = pk_bf16(d[10], d[11]); hi.z = pk_bf16(d[12], d[13]); hi.w = pk_bf16(d[14], d[15]);
        *(u32x4*)(TT + (16 * q + c) * LD + 16 * q) = lo; *(u32x4*)(TT + (16 * q + c) * LD + 16 * q + 8) = hi;
#pragma unroll
        for (int i = 0; i < 16; ++i) Tm[(16 * q + i) * LD + 16 * q + c] = f2bf(d[i]);
    }
    WAVE_SYNC();
    LDS_BARRIER();
#pragma unroll
    for (int P = 0; P < 2; ++P) {
        const int lo = 2 * P, hi = 2 * P + 1;
        const bf16x8 a = fq < 2 ? cvt_frag8(Aab + (16 * hi + fr) * 68 + 16 * lo + 8 * fq) : zf;
        const bf16x8 b = fq < 2 ? *(const bf16x8*)(TT + (16 * lo + fr) * LD + 16 * lo + 8 * fq) : zf;
        const f32x4 e = MFMA16(a, b, ((f32x4){0.f, 0.f, 0.f, 0.f}));
        st_bf4(ET + (P * 16 + fr) * 24 + 4 * fq, e);
    }
    WAVE_SYNC();
#pragma unroll
    for (int P = 0; P < 2; ++P) {
        const int lo = 2 * P, hi = 2 * P + 1;
        const bf16x8 a = fq < 2 ? *(const bf16x8*)(Tm + (16 * hi + fr) * LD + 16 * hi + 8 * fq) : zf;
        const bf16x8 b = fq < 2 ? *(const bf16x8*)(ET + (P * 16 + fr) * 24 + 8 * fq) : zf;
        const f32x4 t = -MFMA16(a, b, ((f32x4){0.f, 0.f, 0.f, 0.f}));
        st_bf4(TT + (16 * lo + fr) * LD + 16 * hi + 4 * fq, t);
#pragma unroll
        for (int j = 0; j < 4; ++j) Tm[(16 * hi + 4 * fq + j) * LD + 16 * lo + fr] = f2bf(t[j]);
    }
    WAVE_SYNC();
#pragma unroll
    for (int mi = 0; mi < 2; ++mi) {
        const bf16x8 a = cvt_frag8(Aab + (32 + 16 * mi + fr) * 68 + 8 * fq);
#pragma unroll
        for (int nc = 0; nc < 2; ++nc) {
            const bf16x8 b = *(const bf16x8*)(TT + (16 * nc + fr) * LD + 8 * fq);
            const f32x4 e = MFMA16(a, b, ((f32x4){0.f, 0.f, 0.f, 0.f}));
            st_bf4(E2T + (16 * nc + fr) * 40 + 16 * mi + 4 * fq, e);
        }
    }
    WAVE_SYNC();
#pragma unroll
    for (int mi = 0; mi < 2; ++mi) {
        const bf16x8 a = *(const bf16x8*)(Tm + (32 + 16 * mi + fr) * LD + 32 + 8 * fq);
#pragma unroll
        for (int nc = 0; nc < 2; ++nc) {
            const bf16x8 b = *(const bf16x8*)(E2T + (16 * nc + fr) * 40 + 8 * fq);
            const f32x4 t = -MFMA16(a, b, ((f32x4){0.f, 0.f, 0.f, 0.f}));
#pragma unroll
            for (int j = 0; j < 4; ++j) Tm[(32 + 16 * mi + 4 * fq + j) * LD + 16 * nc + fr] = f2bf(t[j]);
        }
    }
    LDS_BARRIER();
}

__device__ __forceinline__ void phase_prep(const Params& p, unsigned char* shm) {
    constexpr int LD = 72, LZH = 136, LZS = 200;
    bf16_t* thw = (bf16_t*)shm; bf16_t* tha = thw + 64 * LD; bf16_t* w2T = tha + 64 * LD; bf16_t* a2T = w2T + 64 * LD;
    float* Aab = (float*)shm;
    bf16_t* Tm = (bf16_t*)(shm + 17408); bf16_t* VKt = Tm + 64 * LD;
    bf16_t* Qt = (bf16_t*)(shm + 36864); bf16_t* Kt = Qt + 64 * LD; bf16_t* Bt = Kt + 64 * LD; bf16_t* KKt = Bt + 64 * LD;
    bf16_t* zh = Qt;
    bf16_t* zs = (bf16_t*)(shm + 36864 + 65 * LZH * 2);
    bf16_t* XT = KKt;
    bf16_t* TT = (bf16_t*)(shm + 152064); bf16_t* ET = TT + 64 * LD; bf16_t* E2T = ET;
    bf16_t* KKtT = (bf16_t*)(shm + 73728); bf16_t* VmT = KKtT + 64 * LD; bf16_t* KpT = VmT + 64 * LD; bf16_t* BpT = KpT + 64 * LD;
    bf16_t* YVt = KpT; bf16_t* W1t = BpT; bf16_t* U0t = VmT;
    bf16_t* Aak = (bf16_t*)(shm + 110592); bf16_t* Aqk = Aak + 64 * LD;
    float* red = (float*)Aak; float* tot = red + 256;
    bf16_t* w2P = (bf16_t*)(shm + 131072); bf16_t* a2P = w2P + 64 * LD;
    float* prm = (float*)(shm + 131072 + 18432);
    {
        const int tid0 = threadIdx.x, hh = blockIdx.x & 15;
#pragma unroll
        for (int i = 0; i < 4; ++i) { const int pc = tid0 + 512 * i, mat = pc >> 10, ii = (pc >> 4) & 63, s4 = pc & 15;
            const f32x4 w = *(const f32x4*)((mat ? p.a2 : p.w2) + (size_t)ii * 1024 + hh * 64 + 4 * s4); bf16_t* d = (mat ? a2P : w2P) + (4 * s4) * LD + ii;
            d[0] = f2bf(w[0]); d[LD] = f2bf(w[1]); d[2 * LD] = f2bf(w[2]); d[3 * LD] = f2bf(w[3]); }
        if (tid0 < 64) { const int c = hh * 64 + tid0;
            prm[tid0] = p.w0[c]; prm[64 + tid0] = p.a0[c]; prm[128 + tid0] = p.mu[c]; prm[192 + tid0] = p.mu[1024 + c]; prm[256 + tid0] = p.mu[2048 + c];
            prm[320 + tid0] = p.k_k[c]; prm[384 + tid0] = p.k_a[c]; prm[448 + tid0] = p.r_k[c]; prm[512 + tid0] = p.mu[3072 + tid0]; prm[576 + tid0] = p.mu[3136 + tid0]; }
    }
    u32x4 zpre[6]; int zcol[6], zrow[6], zlds[6];
    {
        const int t0 = threadIdx.x, hh0 = blockIdx.x & 15;
#pragma unroll
        for (int i = 0; i < 6; ++i) { int pc = t0 + 512 * i; const bool ok = pc < 2600; pc = ok ? pc : 2599;
            const bool isH = pc < 1040; const int q = isH ? pc : pc - 1040, r = isH ? q >> 4 : q / 24, rem = isH ? q & 15 : q % 24;
            zcol[i] = isH ? 3072 + 8 * rem : (rem >> 3) * 1024 + hh0 * 64 + 8 * (rem & 7); zrow[i] = r;
            zlds[i] = ok ? (isH ? 36864 + (r * LZH + 8 * rem) * 2 : 36864 + 65 * LZH * 2 + (r * LZS + (rem >> 3) * 64 + 8 * (rem & 7)) * 2) : -1; }
    }
    auto zload = [&](int it) {
        const int rw0 = (it >> 4) * 64;
#pragma unroll
        for (int i = 0; i < 6; ++i) { int grow = rw0 - 1 + zrow[i]; grow = grow < 0 ? 0 : grow; zpre[i] = *(const u32x4*)(p.Z + (size_t)grow * LDZ + ZC_S + zcol[i]); }
    };
    if ((int)blockIdx.x < NCH * 16) zload(blockIdx.x);
    for (int item = blockIdx.x; item < NCH * 16; item += gridDim.x) {
        int tid = threadIdx.x; asm volatile("" : "+v"(tid));
        const int lane = tid & 63, wid = __builtin_amdgcn_readfirstlane(tid >> 6), fr = lane & 15, fq = lane >> 4;
        const int h = item & 15, cidx = item >> 4, row0 = cidx * 64; const size_t chbase = (size_t)item * 4096;
        const int crow = tid >> 3, cseg = (tid & 7) * 8;
        {
            const bool first = seq_first(row0);
#pragma unroll
            for (int i = 0; i < 6; ++i) {
                if (zlds[i] >= 0) {
                    u32x4 v = zpre[i];
                    if ((i == 0 || i == 2) && first && zrow[i] == 0) { v = (u32x4){0u, 0u, 0u, 0u};
                        if (row0 >= MP) { const float* sp = p.st_shift + (size_t)((row0 - MP) >> 6) * NSHIFT + zcol[i]; const f32x4 a = *(const f32x4*)sp, b = *(const f32x4*)(sp + 4);
                            v = (u32x4){pk_bf16(a[0], a[1]), pk_bf16(a[2], a[3]), pk_bf16(b[0], b[1]), pk_bf16(b[2], b[3])}; } }
                    *(u32x4*)(shm + zlds[i]) = v; } }
            const int nitem = item + (int)gridDim.x;
            zload(nitem < NCH * 16 ? nitem : item);
        }
        LDS_BARRIER();
        {
            const int j = tid >> 3, p8 = tid & 7;
#pragma unroll
            for (int isa = 0; isa < 2; ++isa) {
                const int c = isa * 64 + 8 * p8;
                const u32x4 cu = *(const u32x4*)(zh + (j + 1) * LZH + c), pu = *(const u32x4*)(zh + j * LZH + c);
                const f32x4 m0 = *(const f32x4*)(prm + 512 + c), m1 = *(const f32x4*)(prm + 512 + c + 4);
                const unsigned cw[4] = {cu.x, cu.y, cu.z, cu.w}, pw[4] = {pu.x, pu.y, pu.z, pu.w};
                float x[8];
#pragma unroll
                for (int e = 0; e < 4; ++e) { const float c0 = bf_lo(cw[e]), c1 = bf_hi(cw[e]), mA = e < 2 ? m0[2 * e] : m1[2 * e - 4], mB = e < 2 ? m0[2 * e + 1] : m1[2 * e - 3];
                    x[2 * e] = c0 + mA * (bf_lo(pw[e]) - c0); x[2 * e + 1] = c1 + mB * (bf_hi(pw[e]) - c1); }
                if (isa == 0) {
#pragma unroll
                    for (int e = 0; e < 8; ++e) x[e] = tanh_f(x[e]);
                }
                *(u32x4*)((isa ? tha : thw) + j * LD + 8 * p8) = (u32x4){pk_bf16(x[0], x[1]), pk_bf16(x[2], x[3]), pk_bf16(x[4], x[5]), pk_bf16(x[6], x[7])};
            }
            {
                const u32x4 cu = *(const u32x4*)(zs + (j + 1) * LZS + 128 + 8 * p8), pu = *(const u32x4*)(zs + j * LZS + 128 + 8 * p8);
                const f32x4 m0 = *(const f32x4*)(prm + 256 + 8 * p8), m1 = *(const f32x4*)(prm + 256 + 8 * p8 + 4);
                const unsigned cw[4] = {cu.x, cu.y, cu.z, cu.w}, pw[4] = {pu.x, pu.y, pu.z, pu.w};
                float x[8];
#pragma unroll
                for (int e = 0; e < 4; ++e) { const float c0 = bf_lo(cw[e]), c1 = bf_hi(cw[e]), mA = e < 2 ? m0[2 * e] : m1[2 * e - 4], mB = e < 2 ? m0[2 * e + 1] : m1[2 * e - 3];
                    x[2 * e] = c0 + mA * (bf_lo(pw[e]) - c0); x[2 * e + 1] = c1 + mB * (bf_hi(pw[e]) - c1); }
                *(u32x4*)(p.PV + ((size_t)(row0 + j) * 16 + h) * 64 + 8 * p8) = (u32x4){pk_bf16(x[0], x[1]), pk_bf16(x[2], x[3]), pk_bf16(x[4], x[5]), pk_bf16(x[6], x[7])};
            }
        }
        LDS_BARRIER();
        const int tt = wid & 3, chh = wid >> 2, tk = 16 * tt + fr, row = row0 + tk;
        f32x4 lw[2], av[2], vm[2], kkv[2], kp[2], rm[2], cs[2]; float nrm = 0.f, rk = 0.f;
        {
            f32x4 accd[2], acca[2];
#pragma unroll
            for (int n = 0; n < 2; ++n) { accd[n] = (f32x4){0.f, 0.f, 0.f, 0.f}; acca[n] = (f32x4){0.f, 0.f, 0.f, 0.f}; }
#pragma unroll
            for (int ks = 0; ks < 2; ++ks) {
                const bf16x8 bw = ldfrag(thw, LD, 16 * tt, 32 * ks, fr, fq), ba = ldfrag(tha, LD, 16 * tt, 32 * ks, fr, fq);
#pragma unroll
                for (int n = 0; n < 2; ++n) {
                    accd[n] = MFMA16(ldfrag(w2P, LD, 32 * chh + 16 * n, 32 * ks, fr, fq), bw, accd[n]);
                    acca[n] = MFMA16(ldfrag(a2P, LD, 32 * chh + 16 * n, 32 * ks, fr, fq), ba, acca[n]);
                }
            }
            const bf16_t* zc = zs + (tk + 1) * LZS; const bf16_t* zp = zs + tk * LZS;
#pragma unroll
            for (int n = 0; n < 2; ++n) {
                const int c4 = 32 * chh + 16 * n + 4 * fq;
                const f32x4 d = *(const f32x4*)(prm + c4) + accd[n], al = *(const f32x4*)(prm + 64 + c4) + acca[n];
#pragma unroll
                for (int j = 0; j < 4; ++j) { lw[n][j] = -0.87503886f * sigmoid_f(d[j]); av[n][j] = sigmoid_f(al[j]); }
                { const f32x4 vc = ld_bf4(zc + 128 + c4), vp = ld_bf4(zp + 128 + c4); vm[n] = vc + *(const f32x4*)(prm + 256 + c4) * (vp - vc); }
                const f32x4 kc = ld_bf4(zc + 64 + c4), kpv = ld_bf4(zp + 64 + c4);
                const f32x4 k = kc + *(const f32x4*)(prm + 192 + c4) * (kpv - kc);
                kkv[n] = k * *(const f32x4*)(prm + 320 + c4);
                kp[n] = k * (1.0f + (av[n] - 1.0f) * *(const f32x4*)(prm + 384 + c4));
                const f32x4 rc = ld_bf4(zc + c4), rp = ld_bf4(zp + c4);
                rm[n] = rc + *(const f32x4*)(prm + 128 + c4) * (rp - rc);
                const f32x4 rkw = rm[n] * kp[n] * *(const f32x4*)(prm + 448 + c4);
                nrm += kkv[n][0] * kkv[n][0] + kkv[n][1] * kkv[n][1] + kkv[n][2] * kkv[n][2] + kkv[n][3] * kkv[n][3];
                rk += rkw[0] + rkw[1] + rkw[2] + rkw[3];
#pragma unroll
                for (int j = 0; j < 4; ++j) {
                    float x = lw[n][j];
                    x += __int_as_float(__builtin_amdgcn_update_dpp(0, __float_as_int(x), 0x111, 0xf, 0xf, false));
                    x += __int_as_float(__builtin_amdgcn_update_dpp(0, __float_as_int(x), 0x112, 0xf, 0xf, false));
                    x += __int_as_float(__builtin_amdgcn_update_dpp(0, __float_as_int(x), 0x114, 0xf, 0xf, false));
                    x += __int_as_float(__builtin_amdgcn_update_dpp(0, __float_as_int(x), 0x118, 0xf, 0xf, false));
                    cs[n][j] = x;
                }
                if (fr == 15) *(f32x4*)(tot + tt * 64 + c4) = cs[n];
            }
            nrm += __shfl_xor(nrm, 16); nrm += __shfl_xor(nrm, 32);
            rk += __shfl_xor(rk, 16); rk += __shfl_xor(rk, 32);
            if (fq == 0) { red[wid * 16 + fr] = nrm; red[128 + wid * 16 + fr] = rk; }
        }
        LDS_BARRIER();
        {
            nrm += red[(wid ^ 4) * 16 + fr]; rk += red[128 + (wid ^ 4) * 16 + fr];
            const float inv = 1.0f / fmaxf(sqrtf(nrm), 1e-12f);
            p.PRK[(size_t)row * 16 + h] = rk;
#pragma unroll
            for (int n = 0; n < 2; ++n) {
                const int c4 = 32 * chh + 16 * n + 4 * fq;
                f32x4 pre = (f32x4){0.f, 0.f, 0.f, 0.f}, total = (f32x4){0.f, 0.f, 0.f, 0.f};
#pragma unroll
                for (int t2 = 0; t2 < 4; ++t2) { const f32x4 x = *(const f32x4*)(tot + t2 * 64 + c4); total += x; if (t2 < tt) pre += x; }
                const f32x4 csum = pre + cs[n];
                f32x4 eg, eng, egm, etc;
#pragma unroll
                for (int j = 0; j < 4; ++j) { eg[j] = __builtin_amdgcn_exp2f(csum[j]); eng[j] = __builtin_amdgcn_exp2f(-csum[j]); egm[j] = __builtin_amdgcn_exp2f(csum[j] - lw[n][j]); etc[j] = __builtin_amdgcn_exp2f(total[j] - csum[j]); }
                const f32x4 kkn = kkv[n] * inv, bb = kkn * av[n];
                const f32x4 qt = rm[n] * eg, kt = kp[n] * eng, bt = bb * eng, kkt = kkn * egm, kpp = kp[n] * etc, bpp = bb * etc;
                st_bf4(Qt + tk * LD + c4, qt); st_bf4(Kt + tk * LD + c4, kt); st_bf4(Bt + tk * LD + c4, bt);
                const u32x2 kkw = pk_bf4(kkt), vmw = pk_bf4(vm[n]), kpw = pk_bf4(kpp), bpw = pk_bf4(bpp);
                *(u32x2*)(KKt + tk * LD + c4) = kkw;
                { bf16_t* d = KKtT + c4 * LD + tk; d[0] = (bf16_t)kkw.x; d[LD] = (bf16_t)(kkw.x >> 16); d[2 * LD] = (bf16_t)kkw.y; d[3 * LD] = (bf16_t)(kkw.y >> 16); }
                { bf16_t* d = VmT + c4 * LD + tk; d[0] = (bf16_t)vmw.x; d[LD] = (bf16_t)(vmw.x >> 16); d[2 * LD] = (bf16_t)vmw.y; d[3 * LD] = (bf16_t)(vmw.y >> 16); }
                { bf16_t* d = KpT + c4 * LD + tk; d[0] = (bf16_t)kpw.x; d[LD] = (bf16_t)(kpw.x >> 16); d[2 * LD] = (bf16_t)kpw.y; d[3 * LD] = (bf16_t)(kpw.y >> 16); }
                { bf16_t* d = BpT + c4 * LD + tk; d[0] = (bf16_t)bpw.x; d[LD] = (bf16_t)(bpw.x >> 16); d[2 * LD] = (bf16_t)bpw.y; d[3 * LD] = (bf16_t)(bpw.y >> 16); }
                if (tt == 0) { f32x4 g; g[0] = __builtin_amdgcn_exp2f(total[0]); g[1] = __builtin_amdgcn_exp2f(total[1]); g[2] = __builtin_amdgcn_exp2f(total[2]); g[3] = __builtin_amdgcn_exp2f(total[3]); *(f32x4*)(p.GCG + (size_t)item * 64 + c4) = g; }
            }
        }
        LDS_BARRIER();
        {
            const int nt = wid & 3; const bf16x8 b0 = ldfrag(KKt, LD, 16 * nt, 0, fr, fq), b1 = ldfrag(KKt, LD, 16 * nt, 32, fr, fq);
#pragma unroll
            for (int q = 0; q < 2; ++q) {
                const int ms = 2 * (wid >> 2) + q; f32x4 c1 = (f32x4){0.f, 0.f, 0.f, 0.f};
                if (ms <= nt) {
                    c1 = MFMA16(ldfrag(Bt, LD, 16 * ms, 0, fr, fq), b0, c1); c1 = MFMA16(ldfrag(Bt, LD, 16 * ms, 32, fr, fq), b1, c1);
                    if (ms == nt) {
#pragma unroll
                        for (int j = 0; j < 4; ++j) if (4 * fq + j >= fr) c1[j] = 0.f;
                    }
                }
                *(f32x4*)(Aab + (16 * nt + fr) * 68 + 16 * ms + 4 * fq) = c1;
            }
        }
        LDS_BARRIER();
        if (wid == 7) {
            tinv_wave(Aab, Tm, TT, ET, E2T, lane);
        } else {
            for (int pc = tid; pc < 1024; pc += 448) { const int r = (pc & 511) >> 3, sg = (pc & 7) * 8;
                if (pc < 512) *(u32x4*)(p.QG + chbase + r * 64 + sg) = *(const u32x4*)(Qt + r * LD + sg); else *(u32x4*)(p.BPG + chbase + r * 64 + sg) = *(const u32x4*)(BpT + r * LD + sg); }
            for (int idx = wid; idx < 64; idx += 7) {
                const int mat = idx >> 4, nt = (idx >> 2) & 3, ms = idx & 3;
                f32x4 c = (f32x4){0.f, 0.f, 0.f, 0.f};
                if (mat == 3) {
                    c = MFMA16(ldfrag(KpT, LD, 16 * nt, 0, fr, fq), ldfrag(VmT, LD, 16 * ms, 0, fr, fq), c);
                    c = MFMA16(ldfrag(KpT, LD, 16 * nt, 32, fr, fq), ldfrag(VmT, LD, 16 * ms, 32, fr, fq), c);
                    st_bf4(VKt + (16 * ms + fr) * LD + 16 * nt + 4 * fq, c);
                } else {
                    const bf16_t* asrc = mat == 2 ? Bt : Kt; const bf16_t* bsrc = mat == 0 ? KKt : Qt;
                    if (ms <= nt) {
                        c = MFMA16(ldfrag(asrc, LD, 16 * ms, 0, fr, fq), ldfrag(bsrc, LD, 16 * nt, 0, fr, fq), c);
                        c = MFMA16(ldfrag(asrc, LD, 16 * ms, 32, fr, fq), ldfrag(bsrc, LD, 16 * nt, 32, fr, fq), c);
                        if (ms == nt) {
#pragma unroll
                            for (int j = 0; j < 4; ++j) { const int sx = 4 * fq + j; const bool keep = mat ? (sx <= fr) : (sx < fr); if (!keep) c[j] = 0.f; }
                        }
                    }
                    const int tix = 16 * nt + fr, six = 16 * ms + 4 * fq;
                    if (mat == 0) st_bf4(Aak + tix * LD + six, c); else if (mat == 1) st_bf4(Aqk + tix * LD + six, c); else st_bf4(p.AQBG + chbase + tix * 64 + six, c);
                }
            }
            LDS_BARRIER();
            for (int idx = wid; idx < 32; idx += 7) {
                f32x4 c = (f32x4){0.f, 0.f, 0.f, 0.f};
                if (idx < 16) { const int mt = idx >> 2, nv = idx & 3;
                    c = MFMA16(ldfrag(Aak, LD, 16 * mt, 0, fr, fq), ldfrag(VmT, LD, 16 * nv, 0, fr, fq), c);
                    c = MFMA16(ldfrag(Aak, LD, 16 * mt, 32, fr, fq), ldfrag(VmT, LD, 16 * nv, 32, fr, fq), c);
                    st_bf4(XT + (16 * nv + fr) * LD + 16 * mt + 4 * fq, c);
                } else { const int i2 = idx - 16, mv = i2 >> 2, nt = i2 & 3;
                    c = MFMA16(ldfrag(VmT, LD, 16 * mv, 0, fr, fq), ldfrag(Aqk, LD, 16 * nt, 0, fr, fq), c);
                    c = MFMA16(ldfrag(VmT, LD, 16 * mv, 32, fr, fq), ldfrag(Aqk, LD, 16 * nt, 32, fr, fq), c);
                    st_bf4(YVt + (16 * nt + fr) * LD + 16 * mv + 4 * fq, c);
                }
            }
            LDS_BARRIER();
        }
        {
            *(u32x4*)(p.VKG + chbase + crow * 64 + cseg) = *(const u32x4*)(VKt + crow * LD + cseg);
            *(u32x4*)(p.YVG + chbase + crow * 64 + cseg) = *(const u32x4*)(YVt + crow * LD + cseg);
#pragma unroll
            for (int i = 0; i < 4; ++i) {
                const int idx = wid + 8 * i; f32x4 c = (f32x4){0.f, 0.f, 0.f, 0.f};
                if (idx < 16) { const int mk = idx >> 2, nt = idx & 3;
                    c = MFMA16(ldfrag(KKtT, LD, 16 * mk, 0, fr, fq), ldfrag(Tm, LD, 16 * nt, 0, fr, fq), c);
                    c = MFMA16(ldfrag(KKtT, LD, 16 * mk, 32, fr, fq), ldfrag(Tm, LD, 16 * nt, 32, fr, fq), c);
                    st_bf4(W1t + (16 * nt + fr) * LD + 16 * mk + 4 * fq, -c);
                } else { const int i2 = idx - 16, mt = i2 >> 2, nv = i2 & 3;
                    c = MFMA16(ldfrag(Tm, LD, 16 * mt, 0, fr, fq), ldfrag(XT, LD, 16 * nv, 0, fr, fq), c);
                    c = MFMA16(ldfrag(Tm, LD, 16 * mt, 32, fr, fq), ldfrag(XT, LD, 16 * nv, 32, fr, fq), c);
                    st_bf4(U0t + (16 * nv + fr) * LD + 16 * mt + 4 * fq, -c);
                }
            }
        }
        LDS_BARRIER();
        *(u32x4*)(p.W1G + chbase + crow * 64 + cseg) = *(const u32x4*)(W1t + crow * LD + cseg);
        *(u32x4*)(p.U0G + chbase + crow * 64 + cseg) = *(const u32x4*)(U0t + crow * LD + cseg);
    }
}

__device__ __forceinline__ void seq_item(const Params& p, unsigned char* shm, int row0, int nchunks, int h, const float* S0, float* Sout) {
    constexpr int LD = 72, SLOT = 4 * 64 * LD + 128;
    bf16_t* Sb = (bf16_t*)shm; bf16_t* UT = Sb + 64 * LD; bf16_t* ring = UT + 64 * LD;
    const int tid = threadIdx.x, lane = tid & 63, wid = tid >> 6, fr = lane & 15, fq = lane >> 4;
    const int m = wid >> 1, nv0 = 2 * (wid & 1), c0 = 16 * m + 4 * fq;
    const int crow = tid >> 3, cseg = (tid & 7) * 8;
    f32x4 S[2];
#pragma unroll
    for (int q = 0; q < 2; ++q) S[q] = S0 ? *(const f32x4*)(S0 + (16 * (nv0 + q) + fr) * 64 + c0) : (f32x4){0.f, 0.f, 0.f, 0.f};
    const int chi0 = (row0 >> 6) * 16 + h, last = nchunks - 1;
    struct Stage { u32x4 g[4]; f32x4 gc; };
    auto gload = [&](int ci, Stage& G) {
        const size_t cb = (size_t)(chi0 + ci * 16) * 4096 + crow * 64 + cseg;
        G.g[0] = *(const u32x4*)(p.W1G + cb); G.g[1] = *(const u32x4*)(p.BPG + cb); G.g[2] = *(const u32x4*)(p.U0G + cb); G.g[3] = *(const u32x4*)(p.VKG + cb);
        G.gc = *(const f32x4*)(p.GCG + (size_t)(chi0 + ci * 16) * 64 + (tid & 15) * 4);
    };
    auto park = [&](int slot, const Stage& G) {
        bf16_t* d = ring + slot * SLOT;
#pragma unroll
        for (int a = 0; a < 4; ++a) *(u32x4*)(d + a * 64 * LD + crow * LD + cseg) = G.g[a];
        if (tid < 16) *(f32x4*)((float*)(d + 4 * 64 * LD) + tid * 4) = G.gc;
    };
    auto body = [&](int ci, int slot, int pslot, const Stage& G) {
        const bf16_t* W1s = ring + slot * SLOT; const bf16_t* BPs = W1s + 64 * LD; const bf16_t* U0s = BPs + 64 * LD; const bf16_t* VKs = U0s + 64 * LD;
        const float* GCs = (const float*)(VKs + 64 * LD);
        const size_t cb = (size_t)(chi0 + ci * 16) * 4096;
#pragma unroll
        for (int q = 0; q < 2; ++q) *(u32x2*)(Sb + (16 * (nv0 + q) + fr) * LD + c0) = pk_bf4(S[q]);
        LDS_BARRIER();
        park(pslot, G);
        *(u32x4*)(p.Z + (size_t)(row0 + ci * 64 + crow) * LDZ + ZC_S + h * 64 + cseg) = *(const u32x4*)(Sb + crow * LD + cseg);
        const bf16x8 w10 = ldfrag(W1s, LD, 16 * m, 0, fr, fq), w11 = ldfrag(W1s, LD, 16 * m, 32, fr, fq);
#pragma unroll
        for (int q = 0; q < 2; ++q) {
            const int v = 16 * (nv0 + q) + fr;
            f32x4 acc = up_bf4(*(const u32x2*)(U0s + v * LD + c0));
            acc = MFMA16(w10, ldfrag(Sb, LD, 16 * (nv0 + q), 0, fr, fq), acc);
            acc = MFMA16(w11, ldfrag(Sb, LD, 16 * (nv0 + q), 32, fr, fq), acc);
            *(u32x2*)(UT + v * LD + c0) = pk_bf4(acc);
        }
        LDS_BARRIER();
        *(u32x4*)(p.UTG + cb + crow * 64 + cseg) = *(const u32x4*)(UT + crow * LD + cseg);
        const bf16x8 bp0 = ldfrag(BPs, LD, 16 * m, 0, fr, fq), bp1 = ldfrag(BPs, LD, 16 * m, 32, fr, fq);
        const f32x4 gc = *(const f32x4*)(GCs + c0);
#pragma unroll
        for (int q = 0; q < 2; ++q) {
            const int v = 16 * (nv0 + q) + fr;
            f32x4 acc = S[q] * gc + up_bf4(*(const u32x2*)(VKs + v * LD + c0));
            acc = MFMA16(bp0, ldfrag(UT, LD, 16 * (nv0 + q), 0, fr, fq), acc);
            acc = MFMA16(bp1, ldfrag(UT, LD, 16 * (nv0 + q), 32, fr, fq), acc);
            S[q] = acc;
        }
    };
    Stage A, B;
    gload(0, A); gload(min(1, last), B);
    park(0, A); park(1, B);
    gload(min(2, last), A);
    int scur = 0, spark = 2;
    for (int ci = 0; ci < nchunks; ci += 2) {
        gload(min(ci + 3, last), B);
        body(ci, scur, spark, A);
        scur = scur == 2 ? 0 : scur + 1; spark = spark == 2 ? 0 : spark + 1;
        if (ci + 1 >= nchunks) break;
        gload(min(ci + 4, last), A);
        body(ci + 1, scur, spark, B);
        scur = scur == 2 ? 0 : scur + 1; spark = spark == 2 ? 0 : spark + 1;
    }
    LDS_BARRIER();
#pragma unroll
    for (int q = 0; q < 2; ++q) *(f32x4*)(Sout + (16 * (nv0 + q) + fr) * 64 + c0) = S[q];
}

__device__ __forceinline__ void phase_out(const Params& p, unsigned char* shm) {
    constexpr int LD = 72, TILE = 64 * LD, NPAIR = NCH * 8;
    const int tid = threadIdx.x, lane = tid & 63, wid = tid >> 6, fr = lane & 15, fq = lane >> 4;
    const int half = wid >> 2, nt = wid & 3, th = tid & 255, crow = th >> 3, cseg = (th & 7) * 8;
    bf16_t* base = (bf16_t*)shm + half * 7 * TILE;
    bf16_t* SbT = base; bf16_t* UTt = base + TILE; bf16_t* Qt = base + 2 * TILE; bf16_t* AQt = base + 3 * TILE; bf16_t* YVt = base + 4 * TILE; bf16_t* PVt = base + 5 * TILE; bf16_t* GBt = base + 6 * TILE;
    u32x4 g[7][2];
    auto gload = [&](int pr) {
        const int item = 2 * pr + half, h = item & 15, row0 = (item >> 4) * 64; const size_t cb = (size_t)item * 4096;
#pragma unroll
        for (int i = 0; i < 2; ++i) { const int r = crow + 32 * i; const size_t o = cb + r * 64 + cseg;
            g[0][i] = *(const u32x4*)(p.Z + (size_t)(row0 + r) * LDZ + ZC_S + h * 64 + cseg);
            g[1][i] = *(const u32x4*)(p.UTG + o); g[2][i] = *(const u32x4*)(p.QG + o); g[3][i] = *(const u32x4*)(p.AQBG + o); g[4][i] = *(const u32x4*)(p.YVG + o);
            g[5][i] = *(const u32x4*)(p.PV + ((size_t)(row0 + r) * 16 + h) * 64 + cseg);
            g[6][i] = *(const u32x4*)(p.Z + (size_t)(row0 + r) * LDZ + ZC_GB + h * 64 + cseg); }
    };
    if ((int)blockIdx.x < NPAIR) gload(blockIdx.x);
    for (int pr = blockIdx.x; pr < NPAIR; pr += gridDim.x) {
        const int item = 2 * pr + half, h = item & 15, row0 = (item >> 4) * 64;
        const float rk = p.PRK[(size_t)(row0 + 16 * nt + fr) * 16 + h];
        f32x4 gng[4], gnb[4];
#pragma unroll
        for (int mv = 0; mv < 4; ++mv) { gng[mv] = *(const f32x4*)(p.gn_g + h * 64 + 16 * mv + 4 * fq); gnb[mv] = *(const f32x4*)(p.gn_b + h * 64 + 16 * mv + 4 * fq); }
#pragma unroll
        for (int a = 0; a < 7; ++a)
#pragma unroll
            for (int i = 0; i < 2; ++i) *(u32x4*)(base + a * TILE + (crow + 32 * i) * LD + cseg) = g[a][i];
        { const int npr = pr + (int)gridDim.x; gload(npr < NPAIR ? npr : pr); }
        LDS_BARRIER();
        const int trow = 16 * nt + fr;
        f32x4 acc[4];
#pragma unroll
        for (int mv = 0; mv < 4; ++mv) acc[mv] = ld_bf4(YVt + trow * LD + 16 * mv + 4 * fq);
#pragma unroll
        for (int ks = 0; ks < 2; ++ks) {
            const bf16x8 bq = ldfrag(Qt, LD, 16 * nt, 32 * ks, fr, fq), ba = ldfrag(AQt, LD, 16 * nt, 32 * ks, fr, fq);
#pragma unroll
            for (int mv = 0; mv < 4; ++mv) {
                acc[mv] = MFMA16(ldfrag(SbT, LD, 16 * mv, 32 * ks, fr, fq), bq, acc[mv]);
                acc[mv] = MFMA16(ldfrag(UTt, LD, 16 * mv, 32 * ks, fr, fq), ba, acc[mv]);
            }
        }
        float s = 0.f;
#pragma unroll
        for (int mv = 0; mv < 4; ++mv) s += (acc[mv][0] + acc[mv][1]) + (acc[mv][2] + acc[mv][3]);
        s += __shfl_xor(s, 16); s += __shfl_xor(s, 32);
        const float mean = s * (1.0f / 64.0f);
        float q = 0.f;
#pragma unroll
        for (int mv = 0; mv < 4; ++mv) { const f32x4 d = acc[mv] - mean; q += (d[0] * d[0] + d[1] * d[1]) + (d[2] * d[2] + d[3] * d[3]); }
        q += __shfl_xor(q, 16); q += __shfl_xor(q, 32);
        const float rstd = rsqrtf(q * (1.0f / 64.0f) + 64e-5f);
#pragma unroll
        for (int mv = 0; mv < 4; ++mv) {
            const int vch = 16 * mv + 4 * fq;
            const f32x4 vmx = ld_bf4(PVt + trow * LD + vch), gb = ld_bf4(GBt + trow * LD + vch);
            f32x4 o = (acc[mv] - mean) * rstd * gng[mv] + gnb[mv] + rk * vmx;
#pragma unroll
            for (int e = 0; e < 4; ++e) o[e] *= silu_f(gb[e]);
            st_bf4(YVt + trow * LD + vch, o);
        }
        LDS_BARRIER();
#pragma unroll
        for (int i = 0; i < 2; ++i) { const int r = crow + 32 * i; *(u32x4*)(p.ACT + (size_t)(row0 + r) * DM + 1024 + h * 64 + cseg) = *(const u32x4*)(YVt + r * LD + cseg); }
        LDS_BARRIER();
    }
}

__device__ __forceinline__ void sgu_item(const Params& p, unsigned char* shm, int tile, int hbase) {
    constexpr int LDT = 136;
    float* stats = (float*)shm;
    bf16_t* vnT = (bf16_t*)(shm + 1024);
    bf16_t* Wm = vnT + 128 * LDT;
    const int tid = threadIdx.x, lane = tid & 63, wid = tid >> 6, fr = lane & 15, fq = lane >> 4;
    const int row0 = tile * 128; const bool samp = row0 >= MP; const int L = samp ? 64 : 128, Lsh = samp ? 6 : 7;
    for (int q0 = 0; q0 < 16; q0 += 4) {
        u32x4 a[4], b[4];
#pragma unroll
        for (int qq = 0; qq < 4; ++qq) { const bf16_t* zr = p.Z + (size_t)(row0 + wid * 16 + q0 + qq) * LDZ + ZC_V + lane * 16; a[qq] = *(const u32x4*)zr; b[qq] = *(const u32x4*)(zr + 8); }
#pragma unroll
        for (int qq = 0; qq < 4; ++qq) {
            const int j = wid * 16 + q0 + qq;
            const unsigned uu[8] = {a[qq].x, a[qq].y, a[qq].z, a[qq].w, b[qq].x, b[qq].y, b[qq].z, b[qq].w};
            float s = 0.f, s2 = 0.f;
#pragma unroll
            for (int i = 0; i < 8; ++i) { const f32x2 g = gelu2(bf2(uu[i])); s += g.x + g.y; s2 += g.x * g.x + g.y * g.y; }

            s = wave_sum(s); s2 = wave_sum(s2);
            const float mean = s * (1.0f / 1024.0f), var = fmaxf(s2 * (1.0f / 1024.0f) - mean * mean, 0.f);
            if (lane == 0) { stats[2 * j] = mean; stats[2 * j + 1] = rsqrtf(var + 1e-5f); }
        }
    }
    LDS_BARRIER();
    for (int h = hbase; h < hbase + 4; ++h) {
        {
            const int jr = tid >> 4, d0 = (tid & 15) * 8, cg = h * 128 + d0;
            const f32x4 lg0 = *(const f32x4*)(p.ln_g + cg), lg1 = *(const f32x4*)(p.ln_g + cg + 4), lb0 = *(const f32x4*)(p.ln_b + cg), lb1 = *(const f32x4*)(p.ln_b + cg + 4);
            u32x4 zv[4];
#pragma unroll
            for (int ps = 0; ps < 4; ++ps) zv[ps] = *(const u32x4*)(p.Z + (size_t)(row0 + ps * 32 + jr) * LDZ + ZC_V + cg);
#pragma unroll
            for (int ps = 0; ps < 4; ++ps) {
                const int j = ps * 32 + jr; const float mean = stats[2 * j], rstd = stats[2 * j + 1];
                const unsigned uw[4] = {zv[ps].x, zv[ps].y, zv[ps].z, zv[ps].w};
                float vn[8];
#pragma unroll
                for (int e = 0; e < 4; ++e) {
                    const f32x2 g = gelu2(bf2(uw[e]));
                    vn[2 * e] = (g.x - mean) * rstd * (e < 2 ? lg0[2 * e] : lg1[2 * e - 4]) + (e < 2 ? lb0[2 * e] : lb1[2 * e - 4]);
                    vn[2 * e + 1] = (g.y - mean) * rstd * (e < 2 ? lg0[2 * e + 1] : lg1[2 * e - 3]) + (e < 2 ? lb0[2 * e + 1] : lb1[2 * e - 3]);
                }
#pragma unroll
                for (int e = 0; e < 8; ++e) vnT[(d0 + e) * LDT + (j ^ (((tid & 15) & 3) << 3))] = f2bf(vn[e]);
                if (samp) { float* o = p.out + O_SGUV + (size_t)(row0 + j - MP) * 1024 + cg; *(f32x4*)o = (f32x4){vn[0], vn[1], vn[2], vn[3]}; *(f32x4*)(o + 4) = (f32x4){vn[4], vn[5], vn[6], vn[7]}; }
            }
        }
        {
            const int ir = tid >> 5, j4 = (tid & 31) * 4, jl = j4 & (L - 1);
            f32x4 w[8];
#pragma unroll
            for (int ps = 0; ps < 8; ++ps) { const int i = ps * 16 + ir; w[ps] = *(const f32x4*)(p.sgu_w + ((size_t)h * 128 + (i & (L - 1))) * 128 + jl); }
#pragma unroll
            for (int ps = 0; ps < 8; ++ps) {
                const int i = ps * 16 + ir, il = i & (L - 1); const bool same = (i >> Lsh) == (j4 >> Lsh);
#pragma unroll
                for (int e = 0; e < 4; ++e) w[ps][e] = (same && jl + e <= il) ? w[ps][e] : 0.f;
                st_bf4(Wm + i * LDT + j4, w[ps]);
            }
        }
        LDS_BARRIER();
        const int ib = wid >> 1, db = wid & 1;
        f32x4 acc[2][4];
#pragma unroll
        for (int mi = 0; mi < 2; ++mi)
#pragma unroll
            for (int nd = 0; nd < 4; ++nd) acc[mi][nd] = (f32x4){0.f, 0.f, 0.f, 0.f};
        for (int ks = 0; ks <= ib; ++ks) {
            bf16x8 bfr[2], afr[4];
#pragma unroll
            for (int mi = 0; mi < 2; ++mi) bfr[mi] = *(const bf16x8*)(Wm + (32 * ib + 16 * mi + fr) * LDT + ks * 32 + fq * 8);
#pragma unroll
            for (int nd = 0; nd < 4; ++nd) afr[nd] = *(const bf16x8*)(vnT + (64 * db + 16 * nd + fr) * LDT + ((ks * 32 + fq * 8) ^ ((((16 * nd + fr) >> 3) & 3) << 3)));
#pragma unroll
            for (int mi = 0; mi < 2; ++mi)
#pragma unroll
                for (int nd = 0; nd < 4; ++nd) acc[mi][nd] = __builtin_amdgcn_mfma_f32_16x16x32_bf16(afr[nd], bfr[mi], acc[mi][nd], 0, 0, 0);
        }
        LDS_BARRIER();
#pragma unroll
        for (int mi = 0; mi < 2; ++mi)
#pragma unroll
            for (int nd = 0; nd < 4; ++nd) st_bf4(Wm + (32 * ib + 16 * mi + fr) * LDT + 64 * db + 16 * nd + 4 * fq, acc[mi][nd]);
        LDS_BARRIER();
        {
            const int jr = tid >> 4, d0 = (tid & 15) * 8, cg = h * 128 + d0;
            u32x4 uu[4], gg[4];
            float biasv[4];
#pragma unroll
            for (int ps = 0; ps < 4; ++ps) { const bf16_t* zr = p.Z + (size_t)(row0 + ps * 32 + jr) * LDZ + cg; uu[ps] = *(const u32x4*)zr; gg[ps] = *(const u32x4*)(zr + ZC_GA); biasv[ps] = p.sgu_b[h * 128 + ((ps * 32 + jr) & (L - 1))]; }
#pragma unroll
            for (int ps = 0; ps < 4; ++ps) {
                const int i = ps * 32 + jr; const float bias = biasv[ps];
                const u32x4 ff = *(const u32x4*)(Wm + i * LDT + d0);
                const unsigned uw[4] = {uu[ps].x, uu[ps].y, uu[ps].z, uu[ps].w}, gw[4] = {gg[ps].x, gg[ps].y, gg[ps].z, gg[ps].w}, fw[4] = {ff.x, ff.y, ff.z, ff.w};
                unsigned ow[4];
#pragma unroll
                for (int e = 0; e < 4; ++e) { const f32x2 o = gelu2(bf2(uw[e])) * (bf2(fw[e]) + bias) * silu2(bf2(gw[e])); ow[e] = pk_bf16(o.x, o.y); }
                *(u32x4*)(p.ACT + (size_t)(row0 + i) * DM + cg) = (u32x4){ow[0], ow[1], ow[2], ow[3]};
            }
        }
        LDS_BARRIER();
    }
}

__device__ __forceinline__ void phase_mix(const Params& p, unsigned char* shm) {
    constexpr int NSCAN_P = 64, NSCAN_S = 512, NSGU = 2 * (MT / 128);
    const int b = blockIdx.x, G = gridDim.x;
    if (G >= 128) {
        if (b < NSCAN_P) { const int sb = b >> 4, h = b & 15; seq_item(p, shm, sb * SEQ, SEQ / 64, h, nullptr, p.out + O_WKVP + (size_t)(sb * 16 + h) * 4096); return; }
        const int nb = G - NSCAN_P, c = b - NSCAN_P;
        for (int it = c; it < NSCAN_S + NSGU; it += nb) {
            if (it < NSCAN_S) { const int sb = it >> 4, h = it & 15; seq_item(p, shm, MP + sb * DSEQ, 1, h, p.st_wkv + (size_t)(sb * 16 + h) * 4096, p.out + O_WKVS + (size_t)(sb * 16 + h) * 4096); }
            else sgu_item(p, shm, (it - NSCAN_S) >> 1, ((it - NSCAN_S) & 1) * 4);
            __syncthreads();
        }
    } else {
        for (int it = b; it < NSCAN_P + NSCAN_S + NSGU; it += G) {
            if (it < NSCAN_P) { const int sb = it >> 4, h = it & 15; seq_item(p, shm, sb * SEQ, SEQ / 64, h, nullptr, p.out + O_WKVP + (size_t)(sb * 16 + h) * 4096); }
            else if (it < NSCAN_P + NSCAN_S) { const int i2 = it - NSCAN_P, sb = i2 >> 4, h = i2 & 15; seq_item(p, shm, MP + sb * DSEQ, 1, h, p.st_wkv + (size_t)(sb * 16 + h) * 4096, p.out + O_WKVS + (size_t)(sb * 16 + h) * 4096); }
            else sgu_item(p, shm, (it - NSCAN_P - NSCAN_S) >> 1, ((it - NSCAN_P - NSCAN_S) & 1) * 4);
            __syncthreads();
        }
    }
}

__device__ __forceinline__ void phase_final(const Params& p) {
    const int tid = threadIdx.x, lane = tid & 63, wid = tid >> 6;
    f32x4 fg0[4], fg1[4];
#pragma unroll
    for (int i = 0; i < 4; ++i) { const int c = i * 512 + lane * 8; fg0[i] = *(const f32x4*)(p.final_g + c); fg1[i] = *(const f32x4*)(p.final_g + c + 4); }
    for (int row = blockIdx.x * 8 + wid; row < MT; row += gridDim.x * 8) {
        const bf16_t* yr = p.QG + (size_t)row * DM; float* xr = p.out + (size_t)row * DM; const float* xi = xrow(p, row);
        u32x4 v[4]; f32x4 y0[4], y1[4]; float ss = 0.f;
#pragma unroll
        for (int i = 0; i < 4; ++i) { const int c = i * 512 + lane * 8; v[i] = *(const u32x4*)(yr + c); y0[i] = *(const f32x4*)(xi + c); y1[i] = *(const f32x4*)(xi + c + 4); }
#pragma unroll
        for (int i = 0; i < 4; ++i) {
            y0[i] += (f32x4){bf_lo(v[i].x), bf_hi(v[i].x), bf_lo(v[i].y), bf_hi(v[i].y)}; y1[i] += (f32x4){bf_lo(v[i].z), bf_hi(v[i].z), bf_lo(v[i].w), bf_hi(v[i].w)};
            ss += y0[i][0] * y0[i][0] + y0[i][1] * y0[i][1] + y0[i][2] * y0[i][2] + y0[i][3] * y0[i][3] + y1[i][0] * y1[i][0] + y1[i][1] * y1[i][1] + y1[i][2] * y1[i][2] + y1[i][3] * y1[i][3]; }
        ss = wave_sum(ss);
        const float rs = rsqrtf(ss * (1.0f / DM) + 1e-6f);
#pragma unroll
        for (int i = 0; i < 4; ++i) { const int c = i * 512 + lane * 8;
            *(f32x4*)(xr + c) = y0[i] * rs * fg0[i]; *(f32x4*)(xr + c + 4) = y1[i] * rs * fg1[i]; }
    }
}

__device__ __forceinline__ void phase_gemm1(const Params& p, unsigned char* shm) {
    pg8::Gemm g{p.XB, p.WTI, MT, LDZ, DM}; pg8::StaticOrder S; S.init(MT, LDZ, (int)gridDim.x, (int)blockIdx.x);
    EpiZ E{p.Z, p.out};
    pg8::gemm_phase<EpiZ>((LAS unsigned char*)shm, g, S, E);
}
__device__ __forceinline__ void phase_gemm2(const Params& p, unsigned char* shm) {
    pg8::Gemm g{p.ACT, p.WTO, MT, DM, DM}; pg8::StaticOrder S; S.init(MT, DM, (int)gridDim.x, (int)blockIdx.x);
    EpiY E{p.x_prompt, p.x_sample, p.QG};
    pg8::gemm_phase<EpiY>((LAS unsigned char*)shm, g, S, E);
}


#define XB_TMO      128
#define XB_XCNT(j)  (256  + 64 * (j))
#define XB_XSUB(j)  (1280 + 64 * (j))
#define XB_XGEN(j)  (2304 + 64 * (j))
#define XB_TOP      3328
#define XB_TOPGEN   3392
#define XCD_BAR_WORDS 3456
#define XB_SPIN_CAP (1u << 18)
__device__ __forceinline__ unsigned xb_ld(unsigned* p)              { return __hip_atomic_load(p, __ATOMIC_RELAXED, __HIP_MEMORY_SCOPE_AGENT); }
__device__ __forceinline__ unsigned xb_add(unsigned* p, unsigned v) { return __hip_atomic_fetch_add(p, v, __ATOMIC_RELAXED, __HIP_MEMORY_SCOPE_AGENT); }
__device__ __forceinline__ unsigned xb_xcc_id() { return (unsigned)__builtin_amdgcn_s_getreg((3 << 11) | 20) & 0xFu; }
#define XB_SPIN(cond, bar) do { unsigned _sp = 0; while (cond) { __builtin_amdgcn_s_sleep(1); \
    if ((++_sp & 255u) == 0u) { if (xb_ld(&(bar)[XB_TMO])) break; if (_sp > XB_SPIN_CAP) { atomicAdd(&(bar)[XB_TMO], 1u); break; } } } } while (0)
struct XcdBarrier { unsigned* bar; unsigned x, nloc, nx; };
__device__ __forceinline__ XcdBarrier xcd_barrier_post(unsigned* bar) {
    XcdBarrier b; b.bar = bar; b.x = xb_xcc_id(); b.nloc = 0u; b.nx = 0u;
    if (threadIdx.x == 0) (void)xb_add(&bar[XB_XCNT(b.x)], 1u);
    return b;
}
__device__ __forceinline__ void xcd_barrier_complete(unsigned* bar, unsigned x, unsigned& nloc, unsigned& nx) {
    const unsigned G = gridDim.x * gridDim.y * gridDim.z;
    unsigned sum, cnt, mine, sp = 0u;
    for (;;) {
        sum = 0u; cnt = 0u; mine = 0u;
#pragma unroll
        for (unsigned j = 0; j < 16; ++j) { const unsigned c = xb_ld(&bar[XB_XCNT(j)]); sum += c; cnt += (c > 0u) ? 1u : 0u; mine = (j == x) ? c : mine; }
        if (sum == G) break;
        __builtin_amdgcn_s_sleep(1);
        if ((++sp & 255u) == 0u) { if (xb_ld(&bar[XB_TMO])) break; if (sp > XB_SPIN_CAP) { atomicAdd(&bar[XB_TMO], 1u); break; } }
    }
    nloc = mine > 0u ? mine : 1u; nx = cnt > 0u ? cnt : 1u;
}
__device__ __forceinline__ void xcd_barrier(XcdBarrier& b) {
    asm volatile("s_waitcnt vmcnt(0)" ::: "memory");
    __syncthreads();
    if (threadIdx.x == 0) {
        unsigned* bar = b.bar;
        __builtin_amdgcn_s_waitcnt(0);
        if (b.nloc == 0u) xcd_barrier_complete(bar, b.x, b.nloc, b.nx);
        const unsigned nloc = b.nloc, nx = b.nx;
        const unsigned old = xb_add(&bar[XB_XSUB(b.x)], 1u);
        const unsigned gen = old / nloc;
        if (old + 1u == (gen + 1u) * nloc) {
            __builtin_amdgcn_fence(__ATOMIC_RELEASE, "agent");
            asm volatile("s_waitcnt vmcnt(0)" ::: "memory");
            const unsigned og = xb_add(&bar[XB_TOP], 1u);
            const unsigned tg = og / nx;
            if (og + 1u == (tg + 1u) * nx) xb_add(&bar[XB_TOPGEN], 1u);
            else XB_SPIN(xb_ld(&bar[XB_TOPGEN]) == tg, bar);
            __builtin_amdgcn_fence(__ATOMIC_ACQUIRE, "agent");
            xb_add(&bar[XB_XGEN(b.x)], 1u);
            asm volatile("s_waitcnt vmcnt(0)" ::: "memory");
        } else {
            XB_SPIN(xb_ld(&bar[XB_XGEN(b.x)]) == gen, bar);
            __builtin_amdgcn_fence(__ATOMIC_ACQUIRE, "agent");
            asm volatile("s_waitcnt vmcnt(0)" ::: "memory");
        }
    }
    __syncthreads();
}

typedef const __attribute__((address_space(4))) Params* CParams;
__device__ __forceinline__ CParams cp_launder(CParams c) { asm volatile("" : "+s"(c)); return c; }
__global__ __launch_bounds__(512, 2) void k_mega(Params p) {
    extern __shared__ __attribute__((aligned(16))) unsigned char shm[];
    cg::grid_group grid = cg::this_grid();
    CParams cp = (CParams)__builtin_amdgcn_kernarg_segment_ptr();
    XcdBarrier xb = xcd_barrier_post(cp->BAR);
#define P() (*(const Params*)(cp = cp_launder(cp)))
    phase_convert(P(), shm); xcd_barrier(xb);
    if (cp->BAR == nullptr) grid.sync();
    phase_gemm1(P(), shm); xcd_barrier(xb);
    phase_prep(P(), shm); xcd_barrier(xb);
    phase_mix(P(), shm); xcd_barrier(xb);
    phase_out(P(), shm); xcd_barrier(xb);
    phase_gemm2(P(), shm); xcd_barrier(xb);
    phase_final(P());
#undef P
}
template <int PH> __global__ __launch_bounds__(512, 2) void k_one(Params p) {
    extern __shared__ __attribute__((aligned(16))) unsigned char shm[];
    if (PH == 0) phase_convert(p, shm);
    if (PH == 1) phase_gemm1(p, shm);
    if (PH == 2) phase_prep(p, shm);
    if (PH == 3) phase_mix(p, shm);
    if (PH == 4) phase_gemm2(p, shm);
    if (PH == 5) phase_final(p);
    if (PH == 6) phase_out(p, shm);
}

extern "C" void kernel_launch(void* const* d_in, const int* in_sizes, int n_in, void* d_out, int out_size, void* d_ws, size_t ws_size, hipStream_t stream) {
    Params p{};
    const float* const* in = (const float* const*)d_in;
    p.x_prompt = in[0]; p.x_sample = in[1]; p.st_wkv = in[2]; p.st_shift = in[3]; p.norm_g = in[4]; p.w_in = in[5]; p.w_out = in[6]; p.ln_g = in[7]; p.ln_b = in[8];
    p.sgu_w = in[9]; p.sgu_b = in[10]; p.mu = in[11]; p.w0 = in[12]; p.w2 = in[13]; p.a0 = in[14]; p.a2 = in[15]; p.k_k = in[16]; p.k_a = in[17]; p.r_k = in[18];
    p.gn_g = in[19]; p.gn_b = in[20]; p.final_g = in[21];
    p.out = (float*)d_out;
    char* ws = (char*)d_ws; size_t off = 0;
    auto take = [&](size_t bytes) { char* r = ws + off; off += (bytes + 255) & ~(size_t)255; return r; };
    p.Z = (bf16_t*)take((size_t)MT * LDZ * 2);
    p.XB = (bf16_t*)take((size_t)MT * DM * 2); p.ACT = p.XB;
    p.WTI = (bf16_t*)take((size_t)LDZ * DM * 2);
    p.WTO = (bf16_t*)take((size_t)DM * DM * 2);
    const size_t CHB = (size_t)MT * 1024 * 2;
    p.QG = (bf16_t*)take(CHB); p.AQBG = (bf16_t*)take(CHB); p.YVG = (bf16_t*)take(CHB); p.PV = (bf16_t*)take(CHB); p.UTG = (bf16_t*)take(CHB);
    p.PRK = (float*)take((size_t)MT * 16 * 4);
    p.GCG = (float*)take((size_t)NCH * 16 * 64 * 4);
    p.BAR = (unsigned*)take((size_t)XCD_BAR_WORDS * 4);
    if (off > ws_size) { fprintf(stderr, "workspace too small: need %zu have %zu\n", off, ws_size); return; }
    bf16_t* oscr = (bf16_t*)d_out;
    p.W1G = oscr; p.BPG = oscr + (size_t)MT * 1024; p.U0G = oscr + (size_t)2 * MT * 1024; p.VKG = oscr + (size_t)3 * MT * 1024;
#if MEGA
    static int grid_blocks = 0;
    if (!grid_blocks) {
        hipFuncSetAttribute((const void*)k_mega, hipFuncAttributeMaxDynamicSharedMemorySize, LDS_BYTES);
        int dev = 0, cus = 0, per_cu = 0;
        hipGetDevice(&dev);
        hipDeviceGetAttribute(&cus, hipDeviceAttributeMultiprocessorCount, dev);
        hipOccupancyMaxActiveBlocksPerMultiprocessor(&per_cu, k_mega, 512, LDS_BYTES);
        if (per_cu < 1) per_cu = 1;
        grid_blocks = (cus / 16) * 16;
    }
    (void)hipMemsetAsync(p.BAR, 0, (size_t)XCD_BAR_WORDS * 4, stream);
    void* args[] = {&p};
    hipError_t e = hipLaunchCooperativeKernel((const void*)k_mega, dim3(grid_blocks), dim3(512), args, LDS_BYTES, stream);
    if (e != hipSuccess) fprintf(stderr, "cooperative launch failed: %s (grid %d)\n", hipGetErrorString(e), grid_blocks);
#else
    const int G = 256;
    hipFuncSetAttribute((const void*)k_one<0>, hipFuncAttributeMaxDynamicSharedMemorySize, LDS_BYTES);
    hipFuncSetAttribute((const void*)k_one<1>, hipFuncAttributeMaxDynamicSharedMemorySize, LDS_BYTES);
    hipFuncSetAttribute((const void*)k_one<2>, hipFuncAttributeMaxDynamicSharedMemorySize, LDS_BYTES);
    hipFuncSetAttribute((const void*)k_one<3>, hipFuncAttributeMaxDynamicSharedMemorySize, LDS_BYTES);
    hipFuncSetAttribute((const void*)k_one<4>, hipFuncAttributeMaxDynamicSharedMemorySize, LDS_BYTES);
    hipFuncSetAttribute((const void*)k_one<5>, hipFuncAttributeMaxDynamicSharedMemorySize, LDS_BYTES);
    hipFuncSetAttribute((const void*)k_one<6>, hipFuncAttributeMaxDynamicSharedMemorySize, LDS_BYTES);
    k_one<0><<<G, 512, LDS_BYTES, stream>>>(p);
    k_one<1><<<G, 512, LDS_BYTES, stream>>>(p);
    k_one<2><<<G, 512, LDS_BYTES, stream>>>(p);
    k_one<3><<<G, 512, LDS_BYTES, stream>>>(p);
    k_one<6><<<G, 512, LDS_BYTES, stream>>>(p);
    k_one<4><<<G, 512, LDS_BYTES, stream>>>(p);
    k_one<5><<<G, 512, LDS_BYTES, stream>>>(p);
#endif
}
```

```cpp
#include <hip/hip_runtime.h>
#include <hip/hip_cooperative_groups.h>
#include <cstdio>
namespace cg = cooperative_groups;

#ifndef MEGA
#define MEGA 1
#endif

#define LAS __attribute__((address_space(3)))
typedef unsigned short bf16_t;
typedef short bf16x8 __attribute__((ext_vector_type(8)));
typedef float f32x4 __attribute__((ext_vector_type(4)));
typedef float f32x2 __attribute__((ext_vector_type(2)));
typedef unsigned u32x4 __attribute__((ext_vector_type(4)));
typedef unsigned u32x2 __attribute__((ext_vector_type(2)));

constexpr int DM = 2048, MP = 32768, MS = 2048, MT = MP + MS;
constexpr int SEQ = 8192, DSEQ = 64, NSHIFT = 3200, DPROJ = 7296, LDZ = 7424;
constexpr int ZC_V = 1024, ZC_GA = 2048, ZC_S = 3072, ZC_GB = 6272;
constexpr size_t O_YP = 0, O_WKVP = 71303168, O_SHP = 71565312, O_WKVS = 71578112, O_SHS = 73675264, O_SGUV = 73777664;
constexpr int LDS_BYTES = 163840;

struct Params {
    const float *x_prompt, *x_sample, *st_wkv, *st_shift, *norm_g, *w_in, *w_out, *ln_g, *ln_b, *sgu_w, *sgu_b, *mu, *w0, *w2, *a0, *a2, *k_k, *k_a, *r_k, *gn_g, *gn_b, *final_g;
    float* out;
    bf16_t *Z, *XB, *ACT, *WTI, *WTO, *PV, *QG, *AQBG, *YVG, *UTG, *W1G, *BPG, *U0G, *VKG;
    float *PRK, *GCG; unsigned* BAR;
};

typedef __bf16 bf16v2 __attribute__((ext_vector_type(2)));
__device__ __forceinline__ unsigned pk_bf16(float lo, float hi) { const f32x2 v = (f32x2){lo, hi}; const bf16v2 b = __builtin_convertvector(v, bf16v2); return __builtin_bit_cast(unsigned, b); }
__device__ __forceinline__ float bf_lo(unsigned u) { return __uint_as_float(u << 16); }
__device__ __forceinline__ float bf_hi(unsigned u) { return __uint_as_float(u & 0xffff0000u); }
__device__ __forceinline__ float bf2f(bf16_t b) { return __uint_as_float(((unsigned)b) << 16); }
__device__ __forceinline__ bf16_t f2bf(float f) { return (bf16_t)(pk_bf16(f, 0.f) & 0xffffu); }
__device__ __forceinline__ float wave_sum(float v) {
#pragma unroll
    for (int o = 32; o > 0; o >>= 1) v += __shfl_xor(v, o);
    return v;
}
__device__ __forceinline__ float sigmoid_f(float x) { return __builtin_amdgcn_rcpf(1.0f + __builtin_amdgcn_exp2f(-1.44269504089f * x)); }
__device__ __forceinline__ float tanh_f(float x) { return 1.0f - 2.0f * __builtin_amdgcn_rcpf(1.0f + __builtin_amdgcn_exp2f(2.88539008178f * x)); }
__device__ __forceinline__ float silu_f(float x) { return x * __builtin_amdgcn_rcpf(1.0f + __builtin_amdgcn_exp2f(-1.44269504089f * x)); }
__device__ __forceinline__ float gelu_f(float v) {
    const float av = fabsf(v), t = __builtin_amdgcn_rcpf(av * 0.2316418882f + 1.0f);
    float q = t * 0.5307027145f + (-0.7265760135f); q = q * t + 0.7107068705f; q = q * t + (-0.142248368f); q = q * t + 0.127414796f; q = q * t;
    const float e = __builtin_amdgcn_exp2f((v * v) * (-0.72134752044f));
    const float m = v * (q * e);
    return v < 0.f ? m : v - m;
}
__device__ __forceinline__ f32x2 gelu2(f32x2 v) {
    const f32x2 av = __builtin_elementwise_abs(v), d = av * 0.2316418882f + 1.0f;
    f32x2 t; t.x = __builtin_amdgcn_rcpf(d.x); t.y = __builtin_amdgcn_rcpf(d.y);
    f32x2 q = t * 0.5307027145f + (-0.7265760135f); q = q * t + 0.7107068705f; q = q * t + (-0.142248368f); q = q * t + 0.127414796f; q = q * t;
    const f32x2 s = (v * v) * (-0.72134752044f);
    f32x2 e; e.x = __builtin_amdgcn_exp2f(s.x); e.y = __builtin_amdgcn_exp2f(s.y);
    const f32x2 m = av * (q * e);
    return __builtin_elementwise_max(v, (f32x2){0.f, 0.f}) - m;
}
__device__ __forceinline__ f32x2 silu2(f32x2 v) {
    const f32x2 s = v * (-1.44269504089f);
    f32x2 e; e.x = __builtin_amdgcn_exp2f(s.x); e.y = __builtin_amdgcn_exp2f(s.y);
    const f32x2 d = e + 1.0f;
    f32x2 r; r.x = __builtin_amdgcn_rcpf(d.x); r.y = __builtin_amdgcn_rcpf(d.y);
    return v * r;
}
__device__ __forceinline__ f32x2 bf2(unsigned u) { return (f32x2){bf_lo(u), bf_hi(u)}; }
__device__ __forceinline__ f32x2 sigmoid2(f32x2 v) {
    const f32x2 s = v * (-1.44269504089f);
    f32x2 e; e.x = __builtin_amdgcn_exp2f(s.x); e.y = __builtin_amdgcn_exp2f(s.y);
    const f32x2 d = e + 1.0f;
    f32x2 r; r.x = __builtin_amdgcn_rcpf(d.x); r.y = __builtin_amdgcn_rcpf(d.y);
    return r;
}
__device__ __forceinline__ f32x2 tanh2(f32x2 v) {
    const f32x2 s = v * 2.88539008178f;
    f32x2 e; e.x = __builtin_amdgcn_exp2f(s.x); e.y = __builtin_amdgcn_exp2f(s.y);
    const f32x2 d = e + 1.0f;
    f32x2 r; r.x = __builtin_amdgcn_rcpf(d.x); r.y = __builtin_amdgcn_rcpf(d.y);
    return r * (-2.0f) + 1.0f;
}
__device__ __forceinline__ const float* xrow(const Params& p, int row) { return row < MP ? p.x_prompt + (size_t)row * DM : p.x_sample + (size_t)(row - MP) * DM; }
__device__ __forceinline__ bool seq_first(int row) { return row < MP ? (row & (SEQ - 1)) == 0 : ((row - MP) & (DSEQ - 1)) == 0; }

namespace pg8 {
constexpr int BM = 256, BK = 64, HALF = 128, HTB = HALF * BK * 2, STAGE_BYTES = 8 * HTB, NXCD = 8, WGM = 8;
__host__ __device__ __forceinline__ int lds_byte(int r, int c) { const int st = (r >> 4) * 2 + (c >> 5), rr = r & 15, cc = c & 31, ob = rr * 64 + cc * 2; return st * 1024 + (ob ^ (((ob >> 9) & 1) << 5)); }
__host__ __device__ __forceinline__ void stage_rc(int b, int& R, int& C) { const int st = b / 1024, sb = b % 1024, swz = sb ^ (((sb >> 9) & 1) << 5); R = (st >> 1) * 16 + swz / 64; C = (st & 1) * 32 + (swz % 64) / 2; }
__host__ __device__ __forceinline__ int perm32(int rho) { const int n = rho >> 4, i = rho & 15; return 8 * (i >> 2) + 4 * n + (i & 3); }
struct Unit { int pm, pn; };
struct Gemm { const bf16_t* A; const bf16_t* Bt; int M, N, K; };
struct StaticOrder {
    int nM, nN, nwg, G, c;
    __device__ void init(int M, int N, int G_, int c_) { nM = M / BM; nN = N / BM; nwg = nM * nN; G = G_; c = c_; }
    __device__ bool next(int i, Unit& u) const {
        const long L = (long)i * G + c; if (L >= nwg) return false;
        int wgid = (int)L; { const int q = nwg / NXCD, r = nwg % NXCD, xcd = wgid % NXCD, off = wgid / NXCD; wgid = (xcd < r ? xcd * (q + 1) : r * (q + 1) + (xcd - r) * q) + off; }
        const int nig = WGM * nN, gid = wgid / nig, fm = gid * WGM, gsz = (nM - fm) < WGM ? (nM - fm) : WGM;
        u.pm = fm + ((wgid % nig) % gsz); u.pn = (wgid % nig) / gsz; return true;
    }
};

template <class Epi>
__device__ __forceinline__ void gemm_phase(LAS unsigned char* lds, const Gemm g, const StaticOrder& S, const Epi& E) {
    const int tid = threadIdx.x, wid = __builtin_amdgcn_readfirstlane(tid >> 6), lane = tid & 63, wr = wid >> 2, wc = wid & 3, fr = lane & 15, fq = lane >> 4;
    const int K = g.K, nt = K / BK;
    unsigned voffA[2], voffB[2];
#pragma unroll
    for (int i = 0; i < 2; ++i) { int R, C; stage_rc(tid * 16 + i * 8192, R, C); const int Rb = Epi::PERM ? ((R & ~31) + perm32(R & 31)) : R;
        voffA[i] = (unsigned)(R * K + C) * 2u; voffB[i] = (unsigned)(Rb * K + C) * 2u; }
    const size_t kstep = (size_t)(BK * 2);
    const size_t hstep = (size_t)HALF * K * 2;
    const size_t tstep = 2 * hstep;
    const unsigned ldsw = (unsigned)wid * 1024u;
    const int aoff = lds_byte(wr * 64 + fr, fq * 8), boff = lds_byte(wc * 32 + fr, fq * 8);
#define PG8_SA(b, h) (((b) * 2 + (h)) * HTB)
#define PG8_SB(b, h) ((4 + (b) * 2 + (h)) * HTB)
#define PG8_STAGE(bufoff, gbase, voff) do { _Pragma("unroll") for (int _i = 0; _i < 2; ++_i) \
        __builtin_amdgcn_global_load_lds((const unsigned*)((const char*)(gbase) + (voff)[_i]), (LAS unsigned*)(lds + (bufoff) + ldsw + _i * 8192), 16, 0, 0); } while (0)
#define PG8_LDA(dst, b, h) do { _Pragma("unroll") for (int m = 0; m < 4; ++m) _Pragma("unroll") for (int k = 0; k < 2; ++k) dst[m][k] = *(const LAS bf16x8*)(lds + PG8_SA(b, h) + aoff + m * 2048 + k * 1024); } while (0)
#define PG8_LDB(dst, b, h) do { _Pragma("unroll") for (int n = 0; n < 2; ++n) _Pragma("unroll") for (int k = 0; k < 2; ++k) dst[n][k] = *(const LAS bf16x8*)(lds + PG8_SB(b, h) + boff + n * 2048 + k * 1024); } while (0)
#define PG8_MMA(ai, bj, At, Bt) do { __builtin_amdgcn_s_setprio(1); _Pragma("unroll") for (int m = 0; m < 4; ++m) _Pragma("unroll") for (int n = 0; n < 2; ++n) _Pragma("unroll") for (int k = 0; k < 2; ++k) \
        acc[ai][bj][m][n] = __builtin_amdgcn_mfma_f32_16x16x32_bf16(Bt[n][k], At[m][k], acc[ai][bj][m][n], 0, 0, 0); __builtin_amdgcn_s_setprio(0); } while (0)
#define PG8_WAIT_V(n) asm volatile("s_waitcnt vmcnt(" #n ")" ::: "memory")
#define PG8_WAIT_L(n) asm volatile("s_waitcnt lgkmcnt(" #n ")" ::: "memory")
#define PG8_BAR __builtin_amdgcn_s_barrier()
#define PG8_SCHED __builtin_amdgcn_sched_barrier(0)
    Unit cur, nxt; int ui = 0;
    if (!S.next(0, cur)) return;
    f32x4 acc[2][2][4][2];
#pragma unroll
    for (int a = 0; a < 2; ++a)
#pragma unroll
        for (int b = 0; b < 2; ++b)
#pragma unroll
            for (int m = 0; m < 4; ++m)
#pragma unroll
                for (int n = 0; n < 2; ++n) acc[a][b][m][n] = (f32x4){0.f, 0.f, 0.f, 0.f};
    bf16x8 At[4][2], B0[2][2], B1[2][2];
    const char* cA = (const char*)g.A + (size_t)cur.pm * tstep; const char* cB = (const char*)g.Bt + (size_t)cur.pn * tstep;
    PG8_STAGE(PG8_SB(0, 0), cB, voffB); PG8_STAGE(PG8_SA(0, 0), cA, voffA); PG8_STAGE(PG8_SB(0, 1), cB + hstep, voffB); PG8_STAGE(PG8_SA(0, 1), cA + hstep, voffA);
    if (wr == 1) PG8_BAR;
    PG8_WAIT_V(4); PG8_BAR;
    PG8_STAGE(PG8_SB(1, 0), cB + kstep, voffB); PG8_STAGE(PG8_SA(1, 0), cA + kstep, voffA); PG8_STAGE(PG8_SB(1, 1), cB + hstep + kstep, voffB);
    PG8_WAIT_V(6); PG8_BAR;
    for (;;) {
        const bool has_next = S.next(ui + 1, nxt);
        const char* nA = has_next ? (const char*)g.A + (size_t)nxt.pm * tstep : cA; const char* nB = has_next ? (const char*)g.Bt + (size_t)nxt.pn * tstep : cB;
        for (int t = 0; t < nt; t += 2) {
            const bool last = (t == nt - 2);
            const char* a1 = cA + (size_t)(t + 1) * kstep;
            const char* a2 = last ? nA : cA + (size_t)(t + 2) * kstep; const char* b2 = last ? nB : cB + (size_t)(t + 2) * kstep;
            const char* a3 = a2 + kstep; const char* b3 = b2 + kstep;
            PG8_LDB(B0, 0, 0); PG8_SCHED; PG8_LDA(At, 0, 0); PG8_STAGE(PG8_SA(1, 1), a1 + hstep, voffA);
            PG8_WAIT_L(8); PG8_BAR; PG8_WAIT_L(0); PG8_MMA(0, 0, At, B0); PG8_BAR; PG8_SCHED;
            PG8_LDB(B1, 0, 1); PG8_STAGE(PG8_SB(0, 0), b2, voffB);
            PG8_BAR; PG8_WAIT_L(0); PG8_MMA(0, 1, At, B1); PG8_BAR;
            PG8_LDA(At, 0, 1); PG8_STAGE(PG8_SA(0, 0), a2, voffA);
            PG8_BAR; PG8_WAIT_L(0); PG8_MMA(1, 0, At, B0); PG8_BAR; PG8_SCHED;
            PG8_STAGE(PG8_SB(0, 1), b2 + hstep, voffB);
            PG8_WAIT_V(6); PG8_BAR; PG8_MMA(1, 1, At, B1); PG8_BAR;
            PG8_LDB(B0, 1, 0); PG8_SCHED; PG8_LDA(At, 1, 0); PG8_STAGE(PG8_SA(0, 1), a2 + hstep, voffA);
            PG8_WAIT_L(8); PG8_BAR; PG8_WAIT_L(0); PG8_MMA(0, 0, At, B0); PG8_BAR; PG8_SCHED;
            PG8_LDB(B1, 1, 1); PG8_STAGE(PG8_SB(1, 0), b3, voffB);
            PG8_BAR; PG8_WAIT_L(0); PG8_MMA(0, 1, At, B1); PG8_BAR;
            PG8_LDA(At, 1, 1); PG8_STAGE(PG8_SA(1, 0), a3, voffA);
            PG8_BAR; PG8_WAIT_L(0); PG8_MMA(1, 0, At, B0); PG8_BAR; PG8_SCHED;
            PG8_STAGE(PG8_SB(1, 1), b3 + hstep, voffB);
            PG8_WAIT_V(6); PG8_BAR; PG8_MMA(1, 1, At, B1); PG8_BAR;
        }
        E(acc, cur, wr, wc, fr, fq);
        if (!has_next) break;
#pragma unroll
        for (int a = 0; a < 2; ++a)
#pragma unroll
            for (int b = 0; b < 2; ++b)
#pragma unroll
                for (int m = 0; m < 4; ++m)
#pragma unroll
                    for (int n = 0; n < 2; ++n) acc[a][b][m][n] = (f32x4){0.f, 0.f, 0.f, 0.f};
        cur = nxt; cA = nA; cB = nB; ++ui;
    }
    PG8_WAIT_V(0);
    if (wr == 0) PG8_BAR;
    PG8_BAR;
#undef PG8_SA
#undef PG8_SB
#undef PG8_STAGE
#undef PG8_LDA
#undef PG8_LDB
#undef PG8_MMA
#undef PG8_WAIT_V
#undef PG8_WAIT_L
#undef PG8_BAR
#undef PG8_SCHED
}
}

struct EpiZ {
    static constexpr bool PERM = true;
    bf16_t* Z; float* out;
    __device__ __forceinline__ void operator()(const f32x4 (&acc)[2][2][4][2], const pg8::Unit& u, int wr, int wc, int fr, int fq) const {
        const int row0 = u.pm * 256 + wr * 64 + fr, col0 = u.pn * 256 + wc * 32 + 8 * fq;
#pragma unroll
        for (int ai = 0; ai < 2; ++ai)
#pragma unroll
            for (int m = 0; m < 4; ++m) {
                const int row = row0 + ai * 128 + m * 16;
                bf16_t* rowp = Z + (size_t)row * LDZ + col0;
                const bool last = ((row & 63) == 63) && (row >= MP || (row & (SEQ - 1)) == SEQ - 1);
#pragma unroll
                for (int bj = 0; bj < 2; ++bj) {
                    const f32x4 v0 = acc[ai][bj][m][0], v1 = acc[ai][bj][m][1];
                    u32x4 w; w.x = pk_bf16(v0[0], v0[1]); w.y = pk_bf16(v0[2], v0[3]); w.z = pk_bf16(v1[0], v1[1]); w.w = pk_bf16(v1[2], v1[3]);
                    *(u32x4*)(rowp + bj * 128) = w;
                    if (last) {
                        const int c = col0 + bj * 128 - ZC_S;
                        if (c >= 0 && c < NSHIFT) {
                            float* o = row < MP ? out + O_SHP + (size_t)(row >> 13) * NSHIFT + c : out + O_SHS + (size_t)((row - MP) >> 6) * NSHIFT + c;
                            *(f32x4*)o = v0; *(f32x4*)(o + 4) = v1;
                        }
                    }
                }
            }
    }
};
struct EpiY {
    static constexpr bool PERM = true;
    const float *xp, *xs; bf16_t* yb;
    __device__ __forceinline__ void operator()(const f32x4 (&acc)[2][2][4][2], const pg8::Unit& u, int wr, int wc, int fr, int fq) const {
        const int row0 = u.pm * 256 + wr * 64 + fr, col0 = u.pn * 256 + wc * 32 + 8 * fq;
#pragma unroll
        for (int ai = 0; ai < 2; ++ai)
#pragma unroll
            for (int m = 0; m < 4; ++m) {
                const int row = row0 + ai * 128 + m * 16;
                bf16_t* orow = yb + (size_t)row * DM + col0;
#pragma unroll
                for (int bj = 0; bj < 2; ++bj) {
                    const f32x4 v0 = acc[ai][bj][m][0], v1 = acc[ai][bj][m][1];
                    *(u32x4*)(orow + bj * 128) = (u32x4){pk_bf16(v0[0], v0[1]), pk_bf16(v0[2], v0[3]), pk_bf16(v1[0], v1[1]), pk_bf16(v1[2], v1[3])};
                }
            }
    }
};

__device__ __forceinline__ void phase_convert(const Params& p, unsigned char* shm) {
    const int tid = threadIdx.x, lane = tid & 63, wid = tid >> 6;
    for (int row = blockIdx.x * 8 + wid; row < MT; row += gridDim.x * 8) {
        const float* xr = xrow(p, row);
        f32x4 v[8]; float ss = 0.f;
#pragma unroll
        for (int i = 0; i < 8; ++i) { v[i] = *(const f32x4*)(xr + i * 256 + lane * 4); ss += v[i][0] * v[i][0] + v[i][1] * v[i][1] + v[i][2] * v[i][2] + v[i][3] * v[i][3]; }
        ss = wave_sum(ss);
        const float rs = rsqrtf(ss * (1.0f / DM) + 1e-6f);
        bf16_t* o = p.XB + (size_t)row * DM;
#pragma unroll
        for (int i = 0; i < 8; ++i) { u32x2 w; w.x = pk_bf16(v[i][0] * rs, v[i][1] * rs); w.y = pk_bf16(v[i][2] * rs, v[i][3] * rs); *(u32x2*)(o + i * 256 + lane * 4) = w; }
    }
    float* tw = (float*)shm + wid * (64 * 65);
    constexpr int NT_IN = 32 * (LDZ / 64), NT_OUT = 32 * 32;
    for (int tile = blockIdx.x * 8 + wid; tile < NT_IN + NT_OUT; tile += gridDim.x * 8) {
        const bool is_in = tile < NT_IN; const int tl = is_in ? tile : tile - NT_IN;
        const int kt = tl & 31, ntile = tl >> 5, k0 = kt * 64, n0 = ntile * 64;
        const int N = is_in ? DPROJ : DM; const float* w = is_in ? p.w_in : p.w_out; bf16_t* wt = is_in ? p.WTI : p.WTO;
        const bool valid = n0 < N;
        const int rr = lane >> 4, c4 = (lane & 15) * 4;
        f32x4 v[16]; float gsc[16];
#pragma unroll
        for (int i = 0; i < 16; ++i) { const int r = 4 * i + rr; const size_t o = valid ? (size_t)(k0 + r) * N + n0 + c4 : 0; v[i] = *(const f32x4*)(w + o); gsc[i] = p.norm_g[k0 + r]; }
#pragma unroll
        for (int i = 0; i < 16; ++i) { const int r = 4 * i + rr; const float sc = valid ? (is_in ? gsc[i] : 1.0f) : 0.0f; const f32x4 x = v[i] * sc;
            tw[r * 65 + c4] = x[0]; tw[r * 65 + c4 + 1] = x[1]; tw[r * 65 + c4 + 2] = x[2]; tw[r * 65 + c4 + 3] = x[3]; }
        asm volatile("s_waitcnt lgkmcnt(0)" ::: "memory"); __builtin_amdgcn_wave_barrier();
        const int k8 = (lane & 7) * 8;
#pragma unroll
        for (int ps = 0; ps < 8; ++ps) { const int n = ps * 8 + (lane >> 3); float f[8];
#pragma unroll
            for (int j = 0; j < 8; ++j) f[j] = tw[(k8 + j) * 65 + n];
            u32x4 o; o.x = pk_bf16(f[0], f[1]); o.y = pk_bf16(f[2], f[3]); o.z = pk_bf16(f[4], f[5]); o.w = pk_bf16(f[6], f[7]);
            *(u32x4*)(wt + (size_t)(n0 + n) * DM + k0 + k8) = o; }
        asm volatile("s_waitcnt lgkmcnt(0)" ::: "memory"); __builtin_amdgcn_wave_barrier();
    }
}

__device__ __forceinline__ f32x4 ld_bf4(const bf16_t* p) { const u32x2 u = *(const u32x2*)p; return (f32x4){bf_lo(u.x), bf_hi(u.x), bf_lo(u.y), bf_hi(u.y)}; }
__device__ __forceinline__ void st_bf4(bf16_t* p, f32x4 v) { u32x2 u; u.x = pk_bf16(v[0], v[1]); u.y = pk_bf16(v[2], v[3]); *(u32x2*)p = u; }
__device__ __forceinline__ f32x4 zs_prev4(const Params& p, int row, int c) {
    const int prow = row > 0 ? row - 1 : 0, sb = row >= MP ? (row - MP) >> 6 : 0;
    const f32x4 zp = ld_bf4(p.Z + (size_t)prow * LDZ + ZC_S + c), sp = *(const f32x4*)(p.st_shift + (size_t)sb * NSHIFT + c);
    const bool first = seq_first(row), samp = row >= MP;
    f32x4 r;
#pragma unroll
    for (int e = 0; e < 4; ++e) r[e] = first ? (samp ? sp[e] : 0.f) : zp[e];
    return r;
}
#define LDS_BARRIER() do { asm volatile("s_waitcnt lgkmcnt(0)" ::: "memory"); __builtin_amdgcn_s_barrier(); asm volatile("" ::: "memory"); } while (0)
#define MFMA16(a, b, c) __builtin_amdgcn_mfma_f32_16x16x32_bf16(a, b, c, 0, 0, 0)
__device__ __forceinline__ bf16x8 ldfrag(const bf16_t* X, int ld, int row0, int k0, int fr, int fq) { return *(const bf16x8*)(X + (size_t)(row0 + fr) * ld + k0 + 8 * fq); }
__device__ __forceinline__ f32x4 up_bf4(u32x2 u) { return (f32x4){bf_lo(u.x), bf_hi(u.x), bf_lo(u.y), bf_hi(u.y)}; }
__device__ __forceinline__ u32x2 pk_bf4(f32x4 v) { u32x2 u; u.x = pk_bf16(v[0], v[1]); u.y = pk_bf16(v[2], v[3]); return u; }
constexpr int NCH = MT / 64;

__device__ __forceinline__ bf16x8 cvt_frag8(const float* s) {
    const f32x4 a = *(const f32x4*)s, b = *(const f32x4*)(s + 4);
    const u32x4 u = (u32x4){pk_bf16(a[0], a[1]), pk_bf16(a[2], a[3]), pk_bf16(b[0], b[1]), pk_bf16(b[2], b[3])};
    return __builtin_bit_cast(bf16x8, u);
}
#define WAVE_SYNC() do { asm volatile("s_waitcnt lgkmcnt(0)" ::: "memory"); __builtin_amdgcn_wave_barrier(); } while (0)
__device__ __forceinline__ void tinv_wave(const float* Aab, bf16_t* Tm, bf16_t* TT, bf16_t* ET, bf16_t* E2T, int lane) {
    constexpr int LD = 72;
    const int fr = lane & 15, fq = lane >> 4;
    const bf16x8 zf = (bf16x8){0, 0, 0, 0, 0, 0, 0, 0};
    {
        const u32x4 z = (u32x4){0u, 0u, 0u, 0u};
#pragma unroll
        for (int i = 0; i < 9; ++i) { *(u32x4*)(Tm + lane * LD + i * 8) = z; *(u32x4*)(TT + lane * LD + i * 8) = z; }
    }
    WAVE_SYNC();
    {
        const int q = fq, c = fr; const float* Ab = Aab + (16 * q) * 68 + 16 * q;
        float d[16];
#pragma unroll
        for (int i = 0; i < 16; ++i) {
            float a = (i == c) ? 1.0f : 0.0f;
#pragma unroll
            for (int m = 0; m < i; ++m) a -= Ab[i * 68 + m] * d[m];
            d[i] = a;
            if ((i & 3) == 3) __builtin_amdgcn_sched_barrier(0);
        }
        u32x4 lo, hi;
        lo.x = pk_bf16(d[0], d[1]); lo.y = pk_bf16(d[2], d[3]); lo.z = pk_bf16(d[4], d[5]); lo.w = pk_bf16(d[6], d[7]);
        hi.x = pk_bf16(d[8], d[9]); hi.y = pk_bf16(d[10], d[11]); hi.z = pk_bf16(d[12], d[13]); hi.w = pk_bf16(d[14], d[15]);
        *(u32x4*)(TT + (16 * q + c) * LD + 16 * q) = lo; *(u32x4*)(TT + (16 * q + c) * LD + 16 * q + 8) = hi;
#pragma unroll
        for (int i = 0; i < 16; ++i) Tm[(16 * q + i) * LD + 16 * q + c] = f2bf(d[i]);
    }
    WAVE_SYNC();
    LDS_BARRIER();
#pragma unroll
    for (int P = 0; P < 2; ++P) {
        const int lo = 2 * P, hi = 2 * P + 1;
        const bf16x8 a = fq < 2 ? cvt_frag8(Aab + (16 * hi + fr) * 68 + 16 * lo + 8 * fq) : zf;
        const bf16x8 b = fq < 2 ? *(const bf16x8*)(TT + (16 * lo + fr) * LD + 16 * lo + 8 * fq) : zf;
        const f32x4 e = MFMA16(a, b, ((f32x4){0.f, 0.f, 0.f, 0.f}));
        st_bf4(ET + (P * 16 + fr) * 24 + 4 * fq, e);
    }
    WAVE_SYNC();
#pragma unroll
    for (int P = 0; P < 2; ++P) {
        const int lo = 2 * P, hi = 2 * P + 1;
        const bf16x8 a = fq < 2 ? *(const bf16x8*)(Tm + (16 * hi + fr) * LD + 16 * hi + 8 * fq) : zf;
        const bf16x8 b = fq < 2 ? *(const bf16x8*)(ET + (P * 16 + fr) * 24 + 8 * fq) : zf;
        const f32x4 t = -MFMA16(a, b, ((f32x4){0.f, 0.f, 0.f, 0.f}));
        st_bf4(TT + (16 * lo + fr) * LD + 16 * hi + 4 * fq, t);
#pragma unroll
        for (int j = 0; j < 4; ++j) Tm[(16 * hi + 4 * fq + j) * LD + 16 * lo + fr] = f2bf(t[j]);
    }
    WAVE_SYNC();
#pragma unroll
    for (int mi = 0; mi < 2; ++mi) {
        const bf16x8 a = cvt_frag8(Aab + (32 + 16 * mi + fr) * 68 + 8 * fq);
#pragma unroll
        for (int nc = 0; nc < 2; ++nc) {
            const bf16x8 b = *(const bf16x8*)(TT + (16 * nc + fr) * LD + 8 * fq);
            const f32x4 e = MFMA16(a, b, ((f32x4){0.f, 0.f, 0.f, 0.f}));
            st_bf4(E2T + (16 * nc + fr) * 40 + 16 * mi + 4 * fq, e);
        }
    }
    WAVE_SYNC();
#pragma unroll
    for (int mi = 0; mi < 2; ++mi) {
        const bf16x8 a = *(const bf16x8*)(Tm + (32 + 16 * mi + fr) * LD + 32 + 8 * fq);
#pragma unroll
        for (int nc = 0; nc < 2; ++nc) {
            const bf16x8 b = *(const bf16x8*)(E2T + (16 * nc + fr) * 40 + 8 * fq);
            const f32x4 t = -MFMA16(a, b, ((f32x4){0.f, 0.f, 0.f, 0.f}));
#pragma unroll
            for (int j = 0; j < 4; ++j) Tm[(32 + 16 * mi + 4 * fq + j) * LD + 16 * nc + fr] = f2bf(t[j]);
        }
    }
    LDS_BARRIER();
}

__device__ __forceinline__ void phase_prep(const Params& p, unsigned char* shm) {
    constexpr int LD = 72, LZH = 136, LZS = 200;
    bf16_t* thw = (bf16_t*)shm; bf16_t* tha = thw + 64 * LD; bf16_t* w2T = tha + 64 * LD; bf16_t* a2T = w2T + 64 * LD;
    float* Aab = (float*)shm;
    bf16_t* Tm = (bf16_t*)(shm + 17408); bf16_t* VKt = Tm + 64 * LD;
    bf16_t* Qt = (bf16_t*)(shm + 36864); bf16_t* Kt = Qt + 64 * LD; bf16_t* Bt = Kt + 64 * LD; bf16_t* KKt = Bt + 64 * LD;
    bf16_t* zh = Qt;
    bf16_t* zs = (bf16_t*)(shm + 36864 + 65 * LZH * 2);
    bf16_t* XT = KKt;
    bf16_t* TT = (bf16_t*)(shm + 152064); bf16_t* ET = TT + 64 * LD; bf16_t* E2T = ET;
    bf16_t* KKtT = (bf16_t*)(shm + 73728); bf16_t* VmT = KKtT + 64 * LD; bf16_t* KpT = VmT + 64 * LD; bf16_t* BpT = KpT + 64 * LD;
    bf16_t* YVt = KpT; bf16_t* W1t = BpT; bf16_t* U0t = VmT;
    bf16_t* Aak = (bf16_t*)(shm + 110592); bf16_t* Aqk = Aak + 64 * LD;
    float* red = (float*)Aak; float* tot = red + 256;
    bf16_t* w2P = (bf16_t*)(shm + 131072); bf16_t* a2P = w2P + 64 * LD;
    float* prm = (float*)(shm + 131072 + 18432);
    {
        const int tid0 = threadIdx.x, hh = blockIdx.x & 15;
#pragma unroll
        for (int i = 0; i < 4; ++i) { const int pc = tid0 + 512 * i, mat = pc >> 10, ii = (pc >> 4) & 63, s4 = pc & 15;
            const f32x4 w = *(const f32x4*)((mat ? p.a2 : p.w2) + (size_t)ii * 1024 + hh * 64 + 4 * s4); bf16_t* d = (mat ? a2P : w2P) + (4 * s4) * LD + ii;
            d[0] = f2bf(w[0]); d[LD] = f2bf(w[1]); d[2 * LD] = f2bf(w[2]); d[3 * LD] = f2bf(w[3]); }
        if (tid0 < 64) { const int c = hh * 64 + tid0;
            prm[tid0] = p.w0[c]; prm[64 + tid0] = p.a0[c]; prm[128 + tid0] = p.mu[c]; prm[192 + tid0] = p.mu[1024 + c]; prm[256 + tid0] = p.mu[2048 + c];
            prm[320 + tid0] = p.k_k[c]; prm[384 + tid0] = p.k_a[c]; prm[448 + tid0] = p.r_k[c]; prm[512 + tid0] = p.mu[3072 + tid0]; prm[576 + tid0] = p.mu[3136 + tid0]; }
    }
    u32x4 zpre[6]; int zcol[6], zrow[6], zlds[6];
    {
        const int t0 = threadIdx.x, hh0 = blockIdx.x & 15;
#pragma unroll
        for (int i = 0; i < 6; ++i) { int pc = t0 + 512 * i; const bool ok = pc < 2600; pc = ok ? pc : 2599;
            const bool isH = pc < 1040; const int q = isH ? pc : pc - 1040, r = isH ? q >> 4 : q / 24, rem = isH ? q & 15 : q % 24;
            zcol[i] = isH ? 3072 + 8 * rem : (rem >> 3) * 1024 + hh0 * 64 + 8 * (rem & 7); zrow[i] = r;
            zlds[i] = ok ? (isH ? 36864 + (r * LZH + 8 * rem) * 2 : 36864 + 65 * LZH * 2 + (r * LZS + (rem >> 3) * 64 + 8 * (rem & 7)) * 2) : -1; }
    }
    auto zload = [&](int it) {
        const int rw0 = (it >> 4) * 64;
#pragma unroll
        for (int i = 0; i < 6; ++i) { int grow = rw0 - 1 + zrow[i]; grow = grow < 0 ? 0 : grow; zpre[i] = *(const u32x4*)(p.Z + (size_t)grow * LDZ + ZC_S + zcol[i]); }
    };
    if ((int)blockIdx.x < NCH * 16) zload(blockIdx.x);
    for (int item = blockIdx.x; item < NCH * 16; item += gridDim.x) {
        int tid = threadIdx.x; asm volatile("" : "+v"(tid));
        const int lane = tid & 63, wid = __builtin_amdgcn_readfirstlane(tid >> 6), fr = lane & 15, fq = lane >> 4;
        const int h = item & 15, cidx = item >> 4, row0 = cidx * 64; const size_t chbase = (size_t)item * 4096;
        const int crow = tid >> 3, cseg = (tid & 7) * 8;
        {
            const bool first = seq_first(row0);
#pragma unroll
            for (int i = 0; i < 6; ++i) {
                if (zlds[i] >= 0) {
                    u32x4 v = zpre[i];
                    if ((i == 0 || i == 2) && first && zrow[i] == 0) { v = (u32x4){0u, 0u, 0u, 0u};
                        if (row0 >= MP) { const float* sp = p.st_shift + (size_t)((row0 - MP) >> 6) * NSHIFT + zcol[i]; const f32x4 a = *(const f32x4*)sp, b = *(const f32x4*)(sp + 4);
                            v = (u32x4){pk_bf16(a[0], a[1]), pk_bf16(a[2], a[3]), pk_bf16(b[0], b[1]), pk_bf16(b[2], b[3])}; } }
                    *(u32x4*)(shm + zlds[i]) = v; } }
            const int nitem = item + (int)gridDim.x;
            zload(nitem < NCH * 16 ? nitem : item);
        }
        LDS_BARRIER();
        {
            const int j = tid >> 3, p8 = tid & 7;
#pragma unroll
            for (int isa = 0; isa < 2; ++isa) {
                const int c = isa * 64 + 8 * p8;
                const u32x4 cu = *(const u32x4*)(zh + (j + 1) * LZH + c), pu = *(const u32x4*)(zh + j * LZH + c);
                const f32x4 m0 = *(const f32x4*)(prm + 512 + c), m1 = *(const f32x4*)(prm + 512 + c + 4);
                const unsigned cw[4] = {cu.x, cu.y, cu.z, cu.w}, pw[4] = {pu.x, pu.y, pu.z, pu.w};
                float x[8];
#pragma unroll
                for (int e = 0; e < 4; ++e) { const float c0 = bf_lo(cw[e]), c1 = bf_hi(cw[e]), mA = e < 2 ? m0[2 * e] : m1[2 * e - 4], mB = e < 2 ? m0[2 * e + 1] : m1[2 * e - 3];
                    x[2 * e] = c0 + mA * (bf_lo(pw[e]) - c0); x[2 * e + 1] = c1 + mB * (bf_hi(pw[e]) - c1); }
                if (isa == 0) {
#pragma unroll
                    for (int e = 0; e < 4; ++e) { const f32x2 th = tanh2((f32x2){x[2 * e], x[2 * e + 1]}); x[2 * e] = th.x; x[2 * e + 1] = th.y; }
                }
                *(u32x4*)((isa ? tha : thw) + j * LD + 8 * p8) = (u32x4){pk_bf16(x[0], x[1]), pk_bf16(x[2], x[3]), pk_bf16(x[4], x[5]), pk_bf16(x[6], x[7])};
            }
            {
                const u32x4 cu = *(const u32x4*)(zs + (j + 1) * LZS + 128 + 8 * p8), pu = *(const u32x4*)(zs + j * LZS + 128 + 8 * p8);
                const f32x4 m0 = *(const f32x4*)(prm + 256 + 8 * p8), m1 = *(const f32x4*)(prm + 256 + 8 * p8 + 4);
                const unsigned cw[4] = {cu.x, cu.y, cu.z, cu.w}, pw[4] = {pu.x, pu.y, pu.z, pu.w};
                float x[8];
#pragma unroll
                for (int e = 0; e < 4; ++e) { const float c0 = bf_lo(cw[e]), c1 = bf_hi(cw[e]), mA = e < 2 ? m0[2 * e] : m1[2 * e - 4], mB = e < 2 ? m0[2 * e + 1] : m1[2 * e - 3];
                    x[2 * e] = c0 + mA * (bf_lo(pw[e]) - c0); x[2 * e + 1] = c1 + mB * (bf_hi(pw[e]) - c1); }
                *(u32x4*)(p.PV + ((size_t)(row0 + j) * 16 + h) * 64 + 8 * p8) = (u32x4){pk_bf16(x[0], x[1]), pk_bf16(x[2], x[3]), pk_bf16(x[4], x[5]), pk_bf16(x[6], x[7])};
            }
        }
        LDS_BARRIER();
        const int tt = wid & 3, chh = wid >> 2, tk = 16 * tt + fr, row = row0 + tk;
        f32x4 lw[2], av[2], vm[2], kkv[2], kp[2], rm[2], cs[2]; float nrm = 0.f, rk = 0.f;
        {
            f32x4 accd[2], acca[2];
#pragma unroll
            for (int n = 0; n < 2; ++n) { accd[n] = (f32x4){0.f, 0.f, 0.f, 0.f}; acca[n] = (f32x4){0.f, 0.f, 0.f, 0.f}; }
#pragma unroll
            for (int ks = 0; ks < 2; ++ks) {
                const bf16x8 bw = ldfrag(thw, LD, 16 * tt, 32 * ks, fr, fq), ba = ldfrag(tha, LD, 16 * tt, 32 * ks, fr, fq);
#pragma unroll
                for (int n = 0; n < 2; ++n) {
                    accd[n] = MFMA16(ldfrag(w2P, LD, 32 * chh + 16 * n, 32 * ks, fr, fq), bw, accd[n]);
                    acca[n] = MFMA16(ldfrag(a2P, LD, 32 * chh + 16 * n, 32 * ks, fr, fq), ba, acca[n]);
                }
            }
            const bf16_t* zc = zs + (tk + 1) * LZS; const bf16_t* zp = zs + tk * LZS;
#pragma unroll
            for (int n = 0; n < 2; ++n) {
                const int c4 = 32 * chh + 16 * n + 4 * fq;
                const f32x4 d = *(const f32x4*)(prm + c4) + accd[n], al = *(const f32x4*)(prm + 64 + c4) + acca[n];
{ const f32x2 s0 = sigmoid2((f32x2){d[0], d[1]}), s1 = sigmoid2((f32x2){d[2], d[3]}), a0 = sigmoid2((f32x2){al[0], al[1]}), a1 = sigmoid2((f32x2){al[2], al[3]});
                  lw[n] = (f32x4){s0.x, s0.y, s1.x, s1.y} * (-0.87503886f); av[n] = (f32x4){a0.x, a0.y, a1.x, a1.y}; }
                { const f32x4 vc = ld_bf4(zc + 128 + c4), vp = ld_bf4(zp + 128 + c4); vm[n] = vc + *(const f32x4*)(prm + 256 + c4) * (vp - vc); }
                const f32x4 kc = ld_bf4(zc + 64 + c4), kpv = ld_bf4(zp + 64 + c4);
                const f32x4 k = kc + *(const f32x4*)(prm + 192 + c4) * (kpv - kc);
                kkv[n] = k * *(const f32x4*)(prm + 320 + c4);
                kp[n] = k * (1.0f + (av[n] - 1.0f) * *(const f32x4*)(prm + 384 + c4));
                const f32x4 rc = ld_bf4(zc + c4), rp = ld_bf4(zp + c4);
                rm[n] = rc + *(const f32x4*)(prm + 128 + c4) * (rp - rc);
                const f32x4 rkw = rm[n] * kp[n] * *(const f32x4*)(prm + 448 + c4);
                nrm += kkv[n][0] * kkv[n][0] + kkv[n][1] * kkv[n][1] + kkv[n][2] * kkv[n][2] + kkv[n][3] * kkv[n][3];
                rk += rkw[0] + rkw[1] + rkw[2] + rkw[3];
#pragma unroll
                for (int j = 0; j < 4; ++j) {
                    float x = lw[n][j];
                    x += __int_as_float(__builtin_amdgcn_update_dpp(0, __float_as_int(x), 0x111, 0xf, 0xf, false));
                    x += __int_as_float(__builtin_amdgcn_update_dpp(0, __float_as_int(x), 0x112, 0xf, 0xf, false));
                    x += __int_as_float(__builtin_amdgcn_update_dpp(0, __float_as_int(x), 0x114, 0xf, 0xf, false));
                    x += __int_as_float(__builtin_amdgcn_update_dpp(0, __float_as_int(x), 0x118, 0xf, 0xf, false));
                    cs[n][j] = x;
                }
                if (fr == 15) *(f32x4*)(tot + tt * 64 + c4) = cs[n];
            }
            nrm += __shfl_xor(nrm, 16); nrm += __shfl_xor(nrm, 32);
            rk += __shfl_xor(rk, 16); rk += __shfl_xor(rk, 32);
            if (fq == 0) { red[wid * 16 + fr] = nrm; red[128 + wid * 16 + fr] = rk; }
        }
        LDS_BARRIER();
        {
            nrm += red[(wid ^ 4) * 16 + fr]; rk += red[128 + (wid ^ 4) * 16 + fr];
            const float inv = 1.0f / fmaxf(sqrtf(nrm), 1e-12f);
            p.PRK[(size_t)row * 16 + h] = rk;
#pragma unroll
            for (int n = 0; n < 2; ++n) {
                const int c4 = 32 * chh + 16 * n + 4 * fq;
                f32x4 pre = (f32x4){0.f, 0.f, 0.f, 0.f}, total = (f32x4){0.f, 0.f, 0.f, 0.f};
#pragma unroll
                for (int t2 = 0; t2 < 4; ++t2) { const f32x4 x = *(const f32x4*)(tot + t2 * 64 + c4); total += x; if (t2 < tt) pre += x; }
                const f32x4 csum = pre + cs[n];
                f32x4 eg, eng, egm, etc;
#pragma unroll
                for (int j = 0; j < 4; ++j) { eg[j] = __builtin_amdgcn_exp2f(csum[j]); eng[j] = __builtin_amdgcn_exp2f(-csum[j]); egm[j] = __builtin_amdgcn_exp2f(csum[j] - lw[n][j]); etc[j] = __builtin_amdgcn_exp2f(total[j] - csum[j]); }
                const f32x4 kkn = kkv[n] * inv, bb = kkn * av[n];
                const f32x4 qt = rm[n] * eg, kt = kp[n] * eng, bt = bb * eng, kkt = kkn * egm, kpp = kp[n] * etc, bpp = bb * etc;
                st_bf4(Qt + tk * LD + c4, qt); st_bf4(Kt + tk * LD + c4, kt); st_bf4(Bt + tk * LD + c4, bt);
                const u32x2 kkw = pk_bf4(kkt), vmw = pk_bf4(vm[n]), kpw = pk_bf4(kpp), bpw = pk_bf4(bpp);
                *(u32x2*)(KKt + tk * LD + c4) = kkw;
                { bf16_t* d = KKtT + c4 * LD + tk; d[0] = (bf16_t)kkw.x; d[LD] = (bf16_t)(kkw.x >> 16); d[2 * LD] = (bf16_t)kkw.y; d[3 * LD] = (bf16_t)(kkw.y >> 16); }
                { bf16_t* d = VmT + c4 * LD + tk; d[0] = (bf16_t)vmw.x; d[LD] = (bf16_t)(vmw.x >> 16); d[2 * LD] = (bf16_t)vmw.y; d[3 * LD] = (bf16_t)(vmw.y >> 16); }
                { bf16_t* d = KpT + c4 * LD + tk; d[0] = (bf16_t)kpw.x; d[LD] = (bf16_t)(kpw.x >> 16); d[2 * LD] = (bf16_t)kpw.y; d[3 * LD] = (bf16_t)(kpw.y >> 16); }
                { bf16_t* d = BpT + c4 * LD + tk; d[0] = (bf16_t)bpw.x; d[LD] = (bf16_t)(bpw.x >> 16); d[2 * LD] = (bf16_t)bpw.y; d[3 * LD] = (bf16_t)(bpw.y >> 16); }
                if (tt == 0) { f32x4 g; g[0] = __builtin_amdgcn_exp2f(total[0]); g[1] = __builtin_amdgcn_exp2f(total[1]); g[2] = __builtin_amdgcn_exp2f(total[2]); g[3] = __builtin_amdgcn_exp2f(total[3]); *(f32x4*)(p.GCG + (size_t)item * 64 + c4) = g; }
            }
        }
        LDS_BARRIER();
        {
            const int nt = wid & 3; const bf16x8 b0 = ldfrag(KKt, LD, 16 * nt, 0, fr, fq), b1 = ldfrag(KKt, LD, 16 * nt, 32, fr, fq);
#pragma unroll
            for (int q = 0; q < 2; ++q) {
                const int ms = 2 * (wid >> 2) + q; f32x4 c1 = (f32x4){0.f, 0.f, 0.f, 0.f};
                if (ms <= nt) {
                    c1 = MFMA16(ldfrag(Bt, LD, 16 * ms, 0, fr, fq), b0, c1); c1 = MFMA16(ldfrag(Bt, LD, 16 * ms, 32, fr, fq), b1, c1);
                    if (ms == nt) {
#pragma unroll
                        for (int j = 0; j < 4; ++j) if (4 * fq + j >= fr) c1[j] = 0.f;
                    }
                }
                *(f32x4*)(Aab + (16 * nt + fr) * 68 + 16 * ms + 4 * fq) = c1;
            }
        }
        LDS_BARRIER();
        if (wid == 7) {
            tinv_wave(Aab, Tm, TT, ET, E2T, lane);
        } else {
            for (int pc = tid; pc < 1024; pc += 448) { const int r = (pc & 511) >> 3, sg = (pc & 7) * 8;
                if (pc < 512) *(u32x4*)(p.QG + chbase + r * 64 + sg) = *(const u32x4*)(Qt + r * LD + sg); else *(u32x4*)(p.BPG + chbase + r * 64 + sg) = *(const u32x4*)(BpT + r * LD + sg); }
            for (int idx = wid; idx < 64; idx += 7) {
                const int mat = idx >> 4, nt = (idx >> 2) & 3, ms = idx & 3;
                f32x4 c = (f32x4){0.f, 0.f, 0.f, 0.f};
                if (mat == 3) {
                    c = MFMA16(ldfrag(KpT, LD, 16 * nt, 0, fr, fq), ldfrag(VmT, LD, 16 * ms, 0, fr, fq), c);
                    c = MFMA16(ldfrag(KpT, LD, 16 * nt, 32, fr, fq), ldfrag(VmT, LD, 16 * ms, 32, fr, fq), c);
                    st_bf4(VKt + (16 * ms + fr) * LD + 16 * nt + 4 * fq, c);
                } else {
                    const bf16_t* asrc = mat == 2 ? Bt : Kt; const bf16_t* bsrc = mat == 0 ? KKt : Qt;
                    if (ms <= nt) {
                        c = MFMA16(ldfrag(asrc, LD, 16 * ms, 0, fr, fq), ldfrag(bsrc, LD, 16 * nt, 0, fr, fq), c);
                        c = MFMA16(ldfrag(asrc, LD, 16 * ms, 32, fr, fq), ldfrag(bsrc, LD, 16 * nt, 32, fr, fq), c);
                        if (ms == nt) {
#pragma unroll
                            for (int j = 0; j < 4; ++j) { const int sx = 4 * fq + j; const bool keep = mat ? (sx <= fr) : (sx < fr); if (!keep) c[j] = 0.f; }
                        }
                    }
                    const int tix = 16 * nt + fr, six = 16 * ms + 4 * fq;
                    if (mat == 0) st_bf4(Aak + tix * LD + six, c); else if (mat == 1) st_bf4(Aqk + tix * LD + six, c); else st_bf4(p.AQBG + chbase + tix * 64 + six, c);
                }
            }
            LDS_BARRIER();
            for (int idx = wid; idx < 32; idx += 7) {
                f32x4 c = (f32x4){0.f, 0.f, 0.f, 0.f};
                if (idx < 16) { const int mt = idx >> 2, nv = idx & 3;
                    c = MFMA16(ldfrag(Aak, LD, 16 * mt, 0, fr, fq), ldfrag(VmT, LD, 16 * nv, 0, fr, fq), c);
                    c = MFMA16(ldfrag(Aak, LD, 16 * mt, 32, fr, fq), ldfrag(VmT, LD, 16 * nv, 32, fr, fq), c);
                    st_bf4(XT + (16 * nv + fr) * LD + 16 * mt + 4 * fq, c);
                } else { const int i2 = idx - 16, mv = i2 >> 2, nt = i2 & 3;
                    c = MFMA16(ldfrag(VmT, LD, 16 * mv, 0, fr, fq), ldfrag(Aqk, LD, 16 * nt, 0, fr, fq), c);
                    c = MFMA16(ldfrag(VmT, LD, 16 * mv, 32, fr, fq), ldfrag(Aqk, LD, 16 * nt, 32, fr, fq), c);
                    st_bf4(YVt + (16 * nt + fr) * LD + 16 * mv + 4 * fq, c);
                }
            }
            LDS_BARRIER();
        }
        {
            *(u32x4*)(p.VKG + chbase + crow * 64 + cseg) = *(const u32x4*)(VKt + crow * LD + cseg);
            *(u32x4*)(p.YVG + chbase + crow * 64 + cseg) = *(const u32x4*)(YVt + crow * LD + cseg);
#pragma unroll
            for (int i = 0; i < 4; ++i) {
                const int idx = wid + 8 * i; f32x4 c = (f32x4){0.f, 0.f, 0.f, 0.f};
                if (idx < 16) { const int mk = idx >> 2, nt = idx & 3;
                    c = MFMA16(ldfrag(KKtT, LD, 16 * mk, 0, fr, fq), ldfrag(Tm, LD, 16 * nt, 0, fr, fq), c);
                    c = MFMA16(ldfrag(KKtT, LD, 16 * mk, 32, fr, fq), ldfrag(Tm, LD, 16 * nt, 32, fr, fq), c);
                    st_bf4(W1t + (16 * nt + fr) * LD + 16 * mk + 4 * fq, -c);
                } else { const int i2 = idx - 16, mt = i2 >> 2, nv = i2 & 3;
                    c = MFMA16(ldfrag(Tm, LD, 16 * mt, 0, fr, fq), ldfrag(XT, LD, 16 * nv, 0, fr, fq), c);
                    c = MFMA16(ldfrag(Tm, LD, 16 * mt, 32, fr, fq), ldfrag(XT, LD, 16 * nv, 32, fr, fq), c);
                    st_bf4(U0t + (16 * nv + fr) * LD + 16 * mt + 4 * fq, -c);
                }
            }
        }
        LDS_BARRIER();
        *(u32x4*)(p.W1G + chbase + crow * 64 + cseg) = *(const u32x4*)(W1t + crow * LD + cseg);
        *(u32x4*)(p.U0G + chbase + crow * 64 + cseg) = *(const u32x4*)(U0t + crow * LD + cseg);
    }
}

__device__ __forceinline__ void seq_item(const Params& p, unsigned char* shm, int row0, int nchunks, int h, const float* S0, float* Sout) {
    constexpr int LD = 72, SLOT = 4 * 64 * LD + 128;
    bf16_t* Sb = (bf16_t*)shm; bf16_t* UT = Sb + 64 * LD; bf16_t* ring = UT + 64 * LD;
    const int tid = threadIdx.x, lane = tid & 63, wid = tid >> 6, fr = lane & 15, fq = lane >> 4;
    const int m = wid >> 1, nv0 = 2 * (wid & 1), c0 = 16 * m + 4 * fq;
    const int crow = tid >> 3, cseg = (tid & 7) * 8;
    f32x4 S[2];
#pragma unroll
    for (int q = 0; q < 2; ++q) S[q] = S0 ? *(const f32x4*)(S0 + (16 * (nv0 + q) + fr) * 64 + c0) : (f32x4){0.f, 0.f, 0.f, 0.f};
    const int chi0 = (row0 >> 6) * 16 + h, last = nchunks - 1;
    struct Stage { u32x4 g[4]; f32x4 gc; };
    auto gload = [&](int ci, Stage& G) {
        const size_t cb = (size_t)(chi0 + ci * 16) * 4096 + crow * 64 + cseg;
        G.g[0] = *(const u32x4*)(p.W1G + cb); G.g[1] = *(const u32x4*)(p.BPG + cb); G.g[2] = *(const u32x4*)(p.U0G + cb); G.g[3] = *(const u32x4*)(p.VKG + cb);
        G.gc = *(const f32x4*)(p.GCG + (size_t)(chi0 + ci * 16) * 64 + (tid & 15) * 4);
    };
    auto park = [&](int slot, const Stage& G) {
        bf16_t* d = ring + slot * SLOT;
#pragma unroll
        for (int a = 0; a < 4; ++a) *(u32x4*)(d + a * 64 * LD + crow * LD + cseg) = G.g[a];
        if (tid < 16) *(f32x4*)((float*)(d + 4 * 64 * LD) + tid * 4) = G.gc;
    };
    auto body = [&](int ci, int slot, int pslot, const Stage& G) {
        const bf16_t* W1s = ring + slot * SLOT; const bf16_t* BPs = W1s + 64 * LD; const bf16_t* U0s = BPs + 64 * LD; const bf16_t* VKs = U0s + 64 * LD;
        const float* GCs = (const float*)(VKs + 64 * LD);
        const size_t cb = (size_t)(chi0 + ci * 16) * 4096;
#pragma unroll
        for (int q = 0; q < 2; ++q) *(u32x2*)(Sb + (16 * (nv0 + q) + fr) * LD + c0) = pk_bf4(S[q]);
        LDS_BARRIER();
        park(pslot, G);
        *(u32x4*)(p.Z + (size_t)(row0 + ci * 64 + crow) * LDZ + ZC_S + h * 64 + cseg) = *(const u32x4*)(Sb + crow * LD + cseg);
        const bf16x8 w10 = ldfrag(W1s, LD, 16 * m, 0, fr, fq), w11 = ldfrag(W1s, LD, 16 * m, 32, fr, fq);
#pragma unroll
        for (int q = 0; q < 2; ++q) {
            const int v = 16 * (nv0 + q) + fr;
            f32x4 acc = up_bf4(*(const u32x2*)(U0s + v * LD + c0));
            acc = MFMA16(w10, ldfrag(Sb, LD, 16 * (nv0 + q), 0, fr, fq), acc);
            acc = MFMA16(w11, ldfrag(Sb, LD, 16 * (nv0 + q), 32, fr, fq), acc);
            *(u32x2*)(UT + v * LD + c0) = pk_bf4(acc);
        }
        LDS_BARRIER();
        *(u32x4*)(p.UTG + cb + crow * 64 + cseg) = *(const u32x4*)(UT + crow * LD + cseg);
        const bf16x8 bp0 = ldfrag(BPs, LD, 16 * m, 0, fr, fq), bp1 = ldfrag(BPs, LD, 16 * m, 32, fr, fq);
        const f32x4 gc = *(const f32x4*)(GCs + c0);
#pragma unroll
        for (int q = 0; q < 2; ++q) {
            const int v = 16 * (nv0 + q) + fr;
            f32x4 acc = S[q] * gc + up_bf4(*(const u32x2*)(VKs + v * LD + c0));
            acc = MFMA16(bp0, ldfrag(UT, LD, 16 * (nv0 + q), 0, fr, fq), acc);
            acc = MFMA16(bp1, ldfrag(UT, LD, 16 * (nv0 + q), 32, fr, fq), acc);
            S[q] = acc;
        }
    };
    Stage A, B;
    gload(0, A); gload(min(1, last), B);
    park(0, A); park(1, B);
    gload(min(2, last), A);
    int scur = 0, spark = 2;
    for (int ci = 0; ci < nchunks; ci += 2) {
        gload(min(ci + 3, last), B);
        body(ci, scur, spark, A);
        scur = scur == 2 ? 0 : scur + 1; spark = spark == 2 ? 0 : spark + 1;
        if (ci + 1 >= nchunks) break;
        gload(min(ci + 4, last), A);
        body(ci + 1, scur, spark, B);
        scur = scur == 2 ? 0 : scur + 1; spark = spark == 2 ? 0 : spark + 1;
    }
    LDS_BARRIER();
#pragma unroll
    for (int q = 0; q < 2; ++q) *(f32x4*)(Sout + (16 * (nv0 + q) + fr) * 64 + c0) = S[q];
}

__device__ __forceinline__ void phase_out(const Params& p, unsigned char* shm) {
    constexpr int LD = 72, TILE = 64 * LD, NPAIR = NCH * 8;
    const int tid = threadIdx.x, lane = tid & 63, wid = tid >> 6, fr = lane & 15, fq = lane >> 4;
    const int half = wid >> 2, nt = wid & 3, th = tid & 255, crow = th >> 3, cseg = (th & 7) * 8;
    bf16_t* base = (bf16_t*)shm + half * 7 * TILE;
    bf16_t* SbT = base; bf16_t* UTt = base + TILE; bf16_t* Qt = base + 2 * TILE; bf16_t* AQt = base + 3 * TILE; bf16_t* YVt = base + 4 * TILE; bf16_t* PVt = base + 5 * TILE; bf16_t* GBt = base + 6 * TILE;
    u32x4 g[7][2];
    auto gload = [&](int pr) {
        const int item = 2 * pr + half, h = item & 15, row0 = (item >> 4) * 64; const size_t cb = (size_t)item * 4096;
#pragma unroll
        for (int i = 0; i < 2; ++i) { const int r = crow + 32 * i; const size_t o = cb + r * 64 + cseg;
            g[0][i] = *(const u32x4*)(p.Z + (size_t)(row0 + r) * LDZ + ZC_S + h * 64 + cseg);
            g[1][i] = *(const u32x4*)(p.UTG + o); g[2][i] = *(const u32x4*)(p.QG + o); g[3][i] = *(const u32x4*)(p.AQBG + o); g[4][i] = *(const u32x4*)(p.YVG + o);
            g[5][i] = *(const u32x4*)(p.PV + ((size_t)(row0 + r) * 16 + h) * 64 + cseg);
            g[6][i] = *(const u32x4*)(p.Z + (size_t)(row0 + r) * LDZ + ZC_GB + h * 64 + cseg); }
    };
    if ((int)blockIdx.x < NPAIR) gload(blockIdx.x);
    for (int pr = blockIdx.x; pr < NPAIR; pr += gridDim.x) {
        const int item = 2 * pr + half, h = item & 15, row0 = (item >> 4) * 64;
        const float rk = p.PRK[(size_t)(row0 + 16 * nt + fr) * 16 + h];
        f32x4 gng[4], gnb[4];
#pragma unroll
        for (int mv = 0; mv < 4; ++mv) { gng[mv] = *(const f32x4*)(p.gn_g + h * 64 + 16 * mv + 4 * fq); gnb[mv] = *(const f32x4*)(p.gn_b + h * 64 + 16 * mv + 4 * fq); }
#pragma unroll
        for (int a = 0; a < 7; ++a)
#pragma unroll
            for (int i = 0; i < 2; ++i) *(u32x4*)(base + a * TILE + (crow + 32 * i) * LD + cseg) = g[a][i];
        { const int npr = pr + (int)gridDim.x; gload(npr < NPAIR ? npr : pr); }
        LDS_BARRIER();
        const int trow = 16 * nt + fr;
        f32x4 acc[4];
#pragma unroll
        for (int mv = 0; mv < 4; ++mv) acc[mv] = ld_bf4(YVt + trow * LD + 16 * mv + 4 * fq);
#pragma unroll
        for (int ks = 0; ks < 2; ++ks) {
            const bf16x8 bq = ldfrag(Qt, LD, 16 * nt, 32 * ks, fr, fq), ba = ldfrag(AQt, LD, 16 * nt, 32 * ks, fr, fq);
#pragma unroll
            for (int mv = 0; mv < 4; ++mv) {
                acc[mv] = MFMA16(ldfrag(SbT, LD, 16 * mv, 32 * ks, fr, fq), bq, acc[mv]);
                acc[mv] = MFMA16(ldfrag(UTt, LD, 16 * mv, 32 * ks, fr, fq), ba, acc[mv]);
            }
        }
        float s = 0.f;
#pragma unroll
        for (int mv = 0; mv < 4; ++mv) s += (acc[mv][0] + acc[mv][1]) + (acc[mv][2] + acc[mv][3]);
        s += __shfl_xor(s, 16); s += __shfl_xor(s, 32);
        const float mean = s * (1.0f / 64.0f);
        float q = 0.f;
#pragma unroll
        for (int mv = 0; mv < 4; ++mv) { const f32x4 d = acc[mv] - mean; q += (d[0] * d[0] + d[1] * d[1]) + (d[2] * d[2] + d[3] * d[3]); }
        q += __shfl_xor(q, 16); q += __shfl_xor(q, 32);
        const float rstd = rsqrtf(q * (1.0f / 64.0f) + 64e-5f);
#pragma unroll
        for (int mv = 0; mv < 4; ++mv) {
            const int vch = 16 * mv + 4 * fq;
            const f32x4 vmx = ld_bf4(PVt + trow * LD + vch), gb = ld_bf4(GBt + trow * LD + vch);
            f32x4 o = (acc[mv] - mean) * rstd * gng[mv] + gnb[mv] + rk * vmx;
#pragma unroll
            for (int e = 0; e < 4; ++e) o[e] *= silu_f(gb[e]);
            st_bf4(YVt + trow * LD + vch, o);
        }
        LDS_BARRIER();
#pragma unroll
        for (int i = 0; i < 2; ++i) { const int r = crow + 32 * i; *(u32x4*)(p.ACT + (size_t)(row0 + r) * DM + 1024 + h * 64 + cseg) = *(const u32x4*)(YVt + r * LD + cseg); }
        LDS_BARRIER();
    }
}

__device__ __forceinline__ void sgu_item(const Params& p, unsigned char* shm, int tile, int hbase) {
    constexpr int LDT = 136;
    float* stats = (float*)shm;
    bf16_t* vnT = (bf16_t*)(shm + 1024);
    bf16_t* Wm = vnT + 128 * LDT;
    const int tid = threadIdx.x, lane = tid & 63, wid = tid >> 6, fr = lane & 15, fq = lane >> 4;
    const int row0 = tile * 128; const bool samp = row0 >= MP; const int L = samp ? 64 : 128, Lsh = samp ? 6 : 7;
    for (int q0 = 0; q0 < 16; q0 += 4) {
        u32x4 a[4], b[4];
#pragma unroll
        for (int qq = 0; qq < 4; ++qq) { const bf16_t* zr = p.Z + (size_t)(row0 + wid * 16 + q0 + qq) * LDZ + ZC_V + lane * 16; a[qq] = *(const u32x4*)zr; b[qq] = *(const u32x4*)(zr + 8); }
#pragma unroll
        for (int qq = 0; qq < 4; ++qq) {
            const int j = wid * 16 + q0 + qq;
            const unsigned uu[8] = {a[qq].x, a[qq].y, a[qq].z, a[qq].w, b[qq].x, b[qq].y, b[qq].z, b[qq].w};
            float s = 0.f, s2 = 0.f;
#pragma unroll
            for (int i = 0; i < 8; ++i) { const f32x2 g = gelu2(bf2(uu[i])); s += g.x + g.y; s2 += g.x * g.x + g.y * g.y; }

            s = wave_sum(s); s2 = wave_sum(s2);
            const float mean = s * (1.0f / 1024.0f), var = fmaxf(s2 * (1.0f / 1024.0f) - mean * mean, 0.f);
            if (lane == 0) { stats[2 * j] = mean; stats[2 * j + 1] = rsqrtf(var + 1e-5f); }
        }
    }
    LDS_BARRIER();
    for (int h = hbase; h < hbase + 4; ++h) {
        {
            const int jr = tid >> 4, d0 = (tid & 15) * 8, cg = h * 128 + d0;
            const f32x4 lg0 = *(const f32x4*)(p.ln_g + cg), lg1 = *(const f32x4*)(p.ln_g + cg + 4), lb0 = *(const f32x4*)(p.ln_b + cg), lb1 = *(const f32x4*)(p.ln_b + cg + 4);
            u32x4 zv[4];
#pragma unroll
            for (int ps = 0; ps < 4; ++ps) zv[ps] = *(const u32x4*)(p.Z + (size_t)(row0 + ps * 32 + jr) * LDZ + ZC_V + cg);
#pragma unroll
            for (int ps = 0; ps < 4; ++ps) {
                const int j = ps * 32 + jr; const float mean = stats[2 * j], rstd = stats[2 * j + 1];
                const unsigned uw[4] = {zv[ps].x, zv[ps].y, zv[ps].z, zv[ps].w};
                float vn[8];
#pragma unroll
                for (int e = 0; e < 4; ++e) {
                    const f32x2 g = gelu2(bf2(uw[e]));
                    vn[2 * e] = (g.x - mean) * rstd * (e < 2 ? lg0[2 * e] : lg1[2 * e - 4]) + (e < 2 ? lb0[2 * e] : lb1[2 * e - 4]);
                    vn[2 * e + 1] = (g.y - mean) * rstd * (e < 2 ? lg0[2 * e + 1] : lg1[2 * e - 3]) + (e < 2 ? lb0[2 * e + 1] : lb1[2 * e - 3]);
                }
#pragma unroll
                for (int e = 0; e < 8; ++e) vnT[(d0 + e) * LDT + (j ^ (((tid & 15) & 3) << 3))] = f2bf(vn[e]);
                if (samp) { float* o = p.out + O_SGUV + (size_t)(row0 + j - MP) * 1024 + cg; *(f32x4*)o = (f32x4){vn[0], vn[1], vn[2], vn[3]}; *(f32x4*)(o + 4) = (f32x4){vn[4], vn[5], vn[6], vn[7]}; }
            }
        }
        {
            const int ir = tid >> 5, j4 = (tid & 31) * 4, jl = j4 & (L - 1);
            f32x4 w[8];
#pragma unroll
            for (int ps = 0; ps < 8; ++ps) { const int i = ps * 16 + ir; w[ps] = *(const f32x4*)(p.sgu_w + ((size_t)h * 128 + (i & (L - 1))) * 128 + jl); }
#pragma unroll
            for (int ps = 0; ps < 8; ++ps) {
                const int i = ps * 16 + ir, il = i & (L - 1); const bool same = (i >> Lsh) == (j4 >> Lsh);
#pragma unroll
                for (int e = 0; e < 4; ++e) w[ps][e] = (same && jl + e <= il) ? w[ps][e] : 0.f;
                st_bf4(Wm + i * LDT + j4, w[ps]);
            }
        }
        LDS_BARRIER();
        const int ib = wid >> 1, db = wid & 1;
        f32x4 acc[2][4];
#pragma unroll
        for (int mi = 0; mi < 2; ++mi)
#pragma unroll
            for (int nd = 0; nd < 4; ++nd) acc[mi][nd] = (f32x4){0.f, 0.f, 0.f, 0.f};
        for (int ks = 0; ks <= ib; ++ks) {
            bf16x8 bfr[2], afr[4];
#pragma unroll
            for (int mi = 0; mi < 2; ++mi) bfr[mi] = *(const bf16x8*)(Wm + (32 * ib + 16 * mi + fr) * LDT + ks * 32 + fq * 8);
#pragma unroll
            for (int nd = 0; nd < 4; ++nd) afr[nd] = *(const bf16x8*)(vnT + (64 * db + 16 * nd + fr) * LDT + ((ks * 32 + fq * 8) ^ ((((16 * nd + fr) >> 3) & 3) << 3)));
#pragma unroll
            for (int mi = 0; mi < 2; ++mi)
#pragma unroll
                for (int nd = 0; nd < 4; ++nd) acc[mi][nd] = __builtin_amdgcn_mfma_f32_16x16x32_bf16(afr[nd], bfr[mi], acc[mi][nd], 0, 0, 0);
        }
        LDS_BARRIER();
#pragma unroll
        for (int mi = 0; mi < 2; ++mi)
#pragma unroll
            for (int nd = 0; nd < 4; ++nd) st_bf4(Wm + (32 * ib + 16 * mi + fr) * LDT + 64 * db + 16 * nd + 4 * fq, acc[mi][nd]);
        LDS_BARRIER();
        {
            const int jr = tid >> 4, d0 = (tid & 15) * 8, cg = h * 128 + d0;
            u32x4 uu[4], gg[4];
            float biasv[4];
#pragma unroll
            for (int ps = 0; ps < 4; ++ps) { const bf16_t* zr = p.Z + (size_t)(row0 + ps * 32 + jr) * LDZ + cg; uu[ps] = *(const u32x4*)zr; gg[ps] = *(const u32x4*)(zr + ZC_GA); biasv[ps] = p.sgu_b[h * 128 + ((ps * 32 + jr) & (L - 1))]; }
#pragma unroll
            for (int ps = 0; ps < 4; ++ps) {
                const int i = ps * 32 + jr; const float bias = biasv[ps];
                const u32x4 ff = *(const u32x4*)(Wm + i * LDT + d0);
                const unsigned uw[4] = {uu[ps].x, uu[ps].y, uu[ps].z, uu[ps].w}, gw[4] = {gg[ps].x, gg[ps].y, gg[ps].z, gg[ps].w}, fw[4] = {ff.x, ff.y, ff.z, ff.w};
                unsigned ow[4];
#pragma unroll
                for (int e = 0; e < 4; ++e) { const f32x2 o = gelu2(bf2(uw[e])) * (bf2(fw[e]) + bias) * silu2(bf2(gw[e])); ow[e] = pk_bf16(o.x, o.y); }
                *(u32x4*)(p.ACT + (size_t)(row0 + i) * DM + cg) = (u32x4){ow[0], ow[1], ow[2], ow[3]};
            }
        }
        LDS_BARRIER();
    }
}

__device__ __forceinline__ void phase_mix(const Params& p, unsigned char* shm) {
    constexpr int NSCAN_P = 64, NSCAN_S = 512, NSGU = 2 * (MT / 128);
    const int b = blockIdx.x, G = gridDim.x;
    if (G >= 128) {
        if (b < NSCAN_P) { const int sb = b >> 4, h = b & 15; seq_item(p, shm, sb * SEQ, SEQ / 64, h, nullptr, p.out + O_WKVP + (size_t)(sb * 16 + h) * 4096); return; }
        const int nb = G - NSCAN_P, c = b - NSCAN_P;
        for (int it = c; it < NSCAN_S + NSGU; it += nb) {
            if (it < NSCAN_S) { const int sb = it >> 4, h = it & 15; seq_item(p, shm, MP + sb * DSEQ, 1, h, p.st_wkv + (size_t)(sb * 16 + h) * 4096, p.out + O_WKVS + (size_t)(sb * 16 + h) * 4096); }
            else sgu_item(p, shm, (it - NSCAN_S) >> 1, ((it - NSCAN_S) & 1) * 4);
            __syncthreads();
        }
    } else {
        for (int it = b; it < NSCAN_P + NSCAN_S + NSGU; it += G) {
            if (it < NSCAN_P) { const int sb = it >> 4, h = it & 15; seq_item(p, shm, sb * SEQ, SEQ / 64, h, nullptr, p.out + O_WKVP + (size_t)(sb * 16 + h) * 4096); }
            else if (it < NSCAN_P + NSCAN_S) { const int i2 = it - NSCAN_P, sb = i2 >> 4, h = i2 & 15; seq_item(p, shm, MP + sb * DSEQ, 1, h, p.st_wkv + (size_t)(sb * 16 + h) * 4096, p.out + O_WKVS + (size_t)(sb * 16 + h) * 4096); }
            else sgu_item(p, shm, (it - NSCAN_P - NSCAN_S) >> 1, ((it - NSCAN_P - NSCAN_S) & 1) * 4);
            __syncthreads();
        }
    }
}

__device__ __forceinline__ void phase_final(const Params& p) {
    const int tid = threadIdx.x, lane = tid & 63, wid = tid >> 6;
    f32x4 fg0[4], fg1[4];
#pragma unroll
    for (int i = 0; i < 4; ++i) { const int c = i * 512 + lane * 8; fg0[i] = *(const f32x4*)(p.final_g + c); fg1[i] = *(const f32x4*)(p.final_g + c + 4); }
    for (int row = blockIdx.x * 8 + wid; row < MT; row += gridDim.x * 8) {
        const bf16_t* yr = p.QG + (size_t)row * DM; float* xr = p.out + (size_t)row * DM; const float* xi = xrow(p, row);
        u32x4 v[4]; f32x4 y0[4], y1[4]; float ss = 0.f;
#pragma unroll
        for (int i = 0; i < 4; ++i) { const int c = i * 512 + lane * 8; v[i] = *(const u32x4*)(yr + c); y0[i] = *(const f32x4*)(xi + c); y1[i] = *(const f32x4*)(xi + c + 4); }
#pragma unroll
        for (int i = 0; i < 4; ++i) {
            y0[i] += (f32x4){bf_lo(v[i].x), bf_hi(v[i].x), bf_lo(v[i].y), bf_hi(v[i].y)}; y1[i] += (f32x4){bf_lo(v[i].z), bf_hi(v[i].z), bf_lo(v[i].w), bf_hi(v[i].w)};
            ss += y0[i][0] * y0[i][0] + y0[i][1] * y0[i][1] + y0[i][2] * y0[i][2] + y0[i][3] * y0[i][3] + y1[i][0] * y1[i][0] + y1[i][1] * y1[i][1] + y1[i][2] * y1[i][2] + y1[i][3] * y1[i][3]; }
        ss = wave_sum(ss);
        const float rs = rsqrtf(ss * (1.0f / DM) + 1e-6f);
#pragma unroll
        for (int i = 0; i < 4; ++i) { const int c = i * 512 + lane * 8;
            *(f32x4*)(xr + c) = y0[i] * rs * fg0[i]; *(f32x4*)(xr + c + 4) = y1[i] * rs * fg1[i]; }
    }
}

__device__ __forceinline__ void phase_gemm1(const Params& p, unsigned char* shm) {
    pg8::Gemm g{p.XB, p.WTI, MT, LDZ, DM}; pg8::StaticOrder S; S.init(MT, LDZ, (int)gridDim.x, (int)blockIdx.x);
    EpiZ E{p.Z, p.out};
    pg8::gemm_phase<EpiZ>((LAS unsigned char*)shm, g, S, E);
}
__device__ __forceinline__ void phase_gemm2(const Params& p, unsigned char* shm) {
    pg8::Gemm g{p.ACT, p.WTO, MT, DM, DM}; pg8::StaticOrder S; S.init(MT, DM, (int)gridDim.x, (int)blockIdx.x);
    EpiY E{p.x_prompt, p.x_sample, p.QG};
    pg8::gemm_phase<EpiY>((LAS unsigned char*)shm, g, S, E);
}


#define XB_TMO      128
#define XB_XCNT(j)  (256  + 64 * (j))
#define XB_XSUB(j)  (1280 + 64 * (j))
#define XB_XGEN(j)  (2304 + 64 * (j))
#define XB_TOP      3328
#define XB_TOPGEN   3392
#define XCD_BAR_WORDS 3456
#define XB_SPIN_CAP (1u << 18)
__device__ __forceinline__ unsigned xb_ld(unsigned* p)              { return __hip_atomic_load(p, __ATOMIC_RELAXED, __HIP_MEMORY_SCOPE_AGENT); }
__device__ __forceinline__ unsigned xb_add(unsigned* p, unsigned v) { return __hip_atomic_fetch_add(p, v, __ATOMIC_RELAXED, __HIP_MEMORY_SCOPE_AGENT); }
__device__ __forceinline__ unsigned xb_xcc_id() { return (unsigned)__builtin_amdgcn_s_getreg((3 << 11) | 20) & 0xFu; }
#define XB_SPIN(cond, bar) do { unsigned _sp = 0; while (cond) { __builtin_amdgcn_s_sleep(1); \
    if ((++_sp & 255u) == 0u) { if (xb_ld(&(bar)[XB_TMO])) break; if (_sp > XB_SPIN_CAP) { atomicAdd(&(bar)[XB_TMO], 1u); break; } } } } while (0)
struct XcdBarrier { unsigned* bar; unsigned x, nloc, nx; };
__device__ __forceinline__ XcdBarrier xcd_barrier_post(unsigned* bar) {
    XcdBarrier b; b.bar = bar; b.x = xb_xcc_id(); b.nloc = 0u; b.nx = 0u;
    if (threadIdx.x == 0) (void)xb_add(&bar[XB_XCNT(b.x)], 1u);
    return b;
}
__device__ __forceinline__ void xcd_barrier_complete(unsigned* bar, unsigned x, unsigned& nloc, unsigned& nx) {
    const unsigned G = gridDim.x * gridDim.y * gridDim.z;
    unsigned sum, cnt, mine, sp = 0u;
    for (;;) {
        sum = 0u; cnt = 0u; mine = 0u;
#pragma unroll
        for (unsigned j = 0; j < 16; ++j) { const unsigned c = xb_ld(&bar[XB_XCNT(j)]); sum += c; cnt += (c > 0u) ? 1u : 0u; mine = (j == x) ? c : mine; }
        if (sum == G) break;
        __builtin_amdgcn_s_sleep(1);
        if ((++sp & 255u) == 0u) { if (xb_ld(&bar[XB_TMO])) break; if (sp > XB_SPIN_CAP) { atomicAdd(&bar[XB_TMO], 1u); break; } }
    }
    nloc = mine > 0u ? mine : 1u; nx = cnt > 0u ? cnt : 1u;
}
__device__ __forceinline__ void xcd_barrier(XcdBarrier& b) {
    asm volatile("s_waitcnt vmcnt(0)" ::: "memory");
    __syncthreads();
    if (threadIdx.x == 0) {
        unsigned* bar = b.bar;
        __builtin_amdgcn_s_waitcnt(0);
        if (b.nloc == 0u) xcd_barrier_complete(bar, b.x, b.nloc, b.nx);
        const unsigned nloc = b.nloc, nx = b.nx;
        const unsigned old = xb_add(&bar[XB_XSUB(b.x)], 1u);
        const unsigned gen = old / nloc;
        if (old + 1u == (gen + 1u) * nloc) {
            __builtin_amdgcn_fence(__ATOMIC_RELEASE, "agent");
            asm volatile("s_waitcnt vmcnt(0)" ::: "memory");
            const unsigned og = xb_add(&bar[XB_TOP], 1u);
            const unsigned tg = og / nx;
            if (og + 1u == (tg + 1u) * nx) xb_add(&bar[XB_TOPGEN], 1u);
            else XB_SPIN(xb_ld(&bar[XB_TOPGEN]) == tg, bar);
            __builtin_amdgcn_fence(__ATOMIC_ACQUIRE, "agent");
            xb_add(&bar[XB_XGEN(b.x)], 1u);
            asm volatile("s_waitcnt vmcnt(0)" ::: "memory");
        } else {
            XB_SPIN(xb_ld(&bar[XB_XGEN(b.x)]) == gen, bar);
            __builtin_amdgcn_fence(__ATOMIC_ACQUIRE, "agent");
            asm volatile("s_waitcnt vmcnt(0)" ::: "memory");
        }
    }
    __syncthreads();
}

typedef const __attribute__((address_space(4))) Params* CParams;
__device__ __forceinline__ CParams cp_launder(CParams c) { asm volatile("" : "+s"(c)); return c; }
__global__ __launch_bounds__(512, 2) void k_mega(Params p) {
    extern __shared__ __attribute__((aligned(16))) unsigned char shm[];
    cg::grid_group grid = cg::this_grid();
    CParams cp = (CParams)__builtin_amdgcn_kernarg_segment_ptr();
    XcdBarrier xb = xcd_barrier_post(cp->BAR);
#define P() (*(const Params*)(cp = cp_launder(cp)))
    phase_convert(P(), shm); xcd_barrier(xb);
    if (cp->BAR == nullptr) grid.sync();
    phase_gemm1(P(), shm); xcd_barrier(xb);
    phase_prep(P(), shm); xcd_barrier(xb);
    phase_mix(P(), shm); xcd_barrier(xb);
    phase_out(P(), shm); xcd_barrier(xb);
    phase_gemm2(P(), shm); xcd_barrier(xb);
    phase_final(P());
#undef P
}
template <int PH> __global__ __launch_bounds__(512, 2) void k_one(Params p) {
    extern __shared__ __attribute__((aligned(16))) unsigned char shm[];
    if (PH == 0) phase_convert(p, shm);
    if (PH == 1) phase_gemm1(p, shm);
    if (PH == 2) phase_prep(p, shm);
    if (PH == 3) phase_mix(p, shm);
    if (PH == 4) phase_gemm2(p, shm);
    if (PH == 5) phase_final(p);
    if (PH == 6) phase_out(p, shm);
}

extern "C" void kernel_launch(void* const* d_in, const int* in_sizes, int n_in, void* d_out, int out_size, void* d_ws, size_t ws_size, hipStream_t stream) {
    Params p{};
    const float* const* in = (const float* const*)d_in;
    p.x_prompt = in[0]; p.x_sample = in[1]; p.st_wkv = in[2]; p.st_shift = in[3]; p.norm_g = in[4]; p.w_in = in[5]; p.w_out = in[6]; p.ln_g = in[7]; p.ln_b = in[8];
    p.sgu_w = in[9]; p.sgu_b = in[10]; p.mu = in[11]; p.w0 = in[12]; p.w2 = in[13]; p.a0 = in[14]; p.a2 = in[15]; p.k_k = in[16]; p.k_a = in[17]; p.r_k = in[18];
    p.gn_g = in[19]; p.gn_b = in[20]; p.final_g = in[21];
    p.out = (float*)d_out;
    char* ws = (char*)d_ws; size_t off = 0;
    auto take = [&](size_t bytes) { char* r = ws + off; off += (bytes + 255) & ~(size_t)255; return r; };
    p.Z = (bf16_t*)take((size_t)MT * LDZ * 2);
    p.XB = (bf16_t*)take((size_t)MT * DM * 2); p.ACT = p.XB;
    p.WTI = (bf16_t*)take((size_t)LDZ * DM * 2);
    p.WTO = (bf16_t*)take((size_t)DM * DM * 2);
    const size_t CHB = (size_t)MT * 1024 * 2;
    p.QG = (bf16_t*)take(CHB); p.AQBG = (bf16_t*)take(CHB); p.YVG = (bf16_t*)take(CHB); p.PV = (bf16_t*)take(CHB); p.UTG = (bf16_t*)take(CHB);
    p.PRK = (float*)take((size_t)MT * 16 * 4);
    p.GCG = (float*)take((size_t)NCH * 16 * 64 * 4);
    p.BAR = (unsigned*)take((size_t)XCD_BAR_WORDS * 4);
    if (off > ws_size) { fprintf(stderr, "workspace too small: need %zu have %zu\n", off, ws_size); return; }
    bf16_t* oscr = (bf16_t*)d_out;
    p.W1G = oscr; p.BPG = oscr + (size_t)MT * 1024; p.U0G = oscr + (size_t)2 * MT * 1024; p.VKG = oscr + (size_t)3 * MT * 1024;
#if MEGA
    static int grid_blocks = 0;
    if (!grid_blocks) {
        hipFuncSetAttribute((const void*)k_mega, hipFuncAttributeMaxDynamicSharedMemorySize, LDS_BYTES);
        int dev = 0, cus = 0, per_cu = 0;
        hipGetDevice(&dev);
        hipDeviceGetAttribute(&cus, hipDeviceAttributeMultiprocessorCount, dev);
        hipOccupancyMaxActiveBlocksPerMultiprocessor(&per_cu, k_mega, 512, LDS_BYTES);
        if (per_cu < 1) per_cu = 1;
        grid_blocks = (cus / 16) * 16;
    }
    (void)hipMemsetAsync(p.BAR, 0, (size_t)XCD_BAR_WORDS * 4, stream);
    void* args[] = {&p};
    hipError_t e = hipLaunchCooperativeKernel((const void*)k_mega, dim3(grid_blocks), dim3(512), args, LDS_BYTES, stream);
    if (e != hipSuccess) fprintf(stderr, "cooperative launch failed: %s (grid %d)\n", hipGetErrorString(e), grid_blocks);
#else
    const int G = 256;
    hipFuncSetAttribute((const void*)k_one<0>, hipFuncAttributeMaxDynamicSharedMemorySize, LDS_BYTES);
    hipFuncSetAttribute((const void*)k_one<1>, hipFuncAttributeMaxDynamicSharedMemorySize, LDS_BYTES);
    hipFuncSetAttribute((const void*)k_one<2>, hipFuncAttributeMaxDynamicSharedMemorySize, LDS_BYTES);
    hipFuncSetAttribute((const void*)k_one<3>, hipFuncAttributeMaxDynamicSharedMemorySize, LDS_BYTES);
    hipFuncSetAttribute((const void*)k_one<4>, hipFuncAttributeMaxDynamicSharedMemorySize, LDS_BYTES);
    hipFuncSetAttribute((const void*)k_one<5>, hipFuncAttributeMaxDynamicSharedMemorySize, LDS_BYTES);
    hipFuncSetAttribute((const void*)k_one<6>, hipFuncAttributeMaxDynamicSharedMemorySize, LDS_BYTES);
    k_one<0><<<G, 512, LDS_BYTES, stream>>>(p);
    k_one<1><<<G, 512, LDS_BYTES, stream>>>(p);
    k_one<2><<<G, 512, LDS_BYTES, stream>>>(p);
    k_one<3><<<G, 512, LDS_BYTES, stream>>>(p);
    k_one<6><<<G, 512, LDS_BYTES, stream>>>(p);
    k_one<4><<<G, 512, LDS_BYTES, stream>>>(p);
    k_one<5><<<G, 512, LDS_BYTES, stream>>>(p);
#endif
}
```
